# Optimizing an MI355X kernel written in HIP

```python
import math
import jax, jax.numpy as jnp
from jax import lax
import numpy as np

D_MODEL = 2048
BATCH = 2
SEQ = 16384
DEPTH = 2

N_META = 16
EPS = 1e-6
NEG = -1e30

ATT_HEADS = 16
ATT_KV_HEADS = 2
ATT_HEAD_DIM = 64
WINDOW = 128
ATT_BLOCK = 128
N_BUCKETS = 32
MAX_DISTANCE = 128

SSD_HEADS = 16
SSD_HEAD_DIM = 64
SSD_INNER = SSD_HEADS * SSD_HEAD_DIM
SSD_GROUPS = 4
SSD_STATE = 128
SSD_CONV = 4
SSD_CHUNK = 128

HG_HEADS = 8
HG_KEY_DIM = 128
HG_VAL_DIM = 128
HG_CHUNK = 16

D_FF = 5632
FFN_CONV = 3

ATT_Q = ATT_HEADS * ATT_HEAD_DIM
ATT_KV = ATT_KV_HEADS * ATT_HEAD_DIM
SSD_XBC = SSD_INNER + 2 * SSD_GROUPS * SSD_STATE
HG_K = HG_HEADS * HG_KEY_DIM
HG_V = HG_HEADS * HG_VAL_DIM
N_BRANCH = 3
BRANCH_WIDTH = 1024
IN_SIZES = (ATT_Q, ATT_KV, ATT_KV, SSD_INNER, SSD_XBC, SSD_HEADS, HG_K, HG_K, HG_V, HG_V, N_BRANCH * D_MODEL)
D_IN = ATT_Q + 2 * ATT_KV + SSD_INNER + SSD_XBC + SSD_HEADS + 2 * HG_K + 2 * HG_V + N_BRANCH * D_MODEL

kernel_name = "hybrid_swa_ssd_hgrn2_gated_merge"


def rmsnorm(x, w):
    xf = x.astype(jnp.float32)
    y = xf * lax.rsqrt(jnp.mean(xf * xf, axis=-1, keepdims=True) + EPS)
    return (y * w.astype(jnp.float32)).astype(x.dtype)


def causal_dwconv(x, w, b):
    K = w.shape[0]
    L = x.shape[1]
    xp = jnp.pad(x, ((0, 0), (K - 1, 0), (0, 0)))
    w = w.astype(x.dtype)
    y = b.astype(x.dtype)
    for k in range(K):
        y = y + xp[:, k:k + L] * w[k]
    return y


def masked_exp(mask, logdiff):
    return jnp.where(mask, jnp.exp(jnp.where(mask, logdiff, 0.0)), 0.0)


def t5_bucket(dist):
    n = jnp.maximum(dist, 0)
    max_exact = N_BUCKETS // 2
    nf = jnp.maximum(n, max_exact).astype(jnp.float32)
    large = max_exact + (jnp.log(nf / max_exact) / math.log(MAX_DISTANCE / max_exact)
                         * (N_BUCKETS - max_exact)).astype(jnp.int32)
    large = jnp.minimum(large, N_BUCKETS - 1)
    return jnp.where(n < max_exact, n, large)


def sliding_window_attention(q, k, v, sinks, rel_bias):
    Bsz, L = q.shape[0], q.shape[1]
    G, R, Dh, BLK = ATT_KV_HEADS, ATT_HEADS // ATT_KV_HEADS, ATT_HEAD_DIM, ATT_BLOCK
    pad = BLK - N_META
    nb = (L + pad) // BLK

    def to_blocks(t):
        t = jnp.pad(t, ((0, 0), (pad, 0), (0, 0), (0, 0)))
        return t.reshape((Bsz, nb, BLK) + t.shape[2:])

    def band(t):
        prev = jnp.pad(t, ((0, 0), (1, 0), (0, 0), (0, 0), (0, 0)))[:, :-1]
        return jnp.concatenate([prev, t], axis=2)

    qb = to_blocks(q).reshape(Bsz, nb, BLK, G, R, Dh)
    k_band, v_band = band(to_blocks(k)), band(to_blocks(v))
    k_meta, v_meta = k[:, :N_META], v[:, :N_META]
    scale = Dh ** -0.5
    s_band = jnp.einsum('bnqgrd,bnkgd->bgrnqk', qb, k_band).astype(jnp.float32) * scale
    s_meta = jnp.einsum('bnqgrd,bmgd->bgrnqm', qb, k_meta).astype(jnp.float32) * scale

    i = jnp.arange(BLK)[:, None]
    j = jnp.arange(2 * BLK)[None, :]
    blk = jnp.arange(nb)[:, None, None]
    d_band = BLK + i - j
    band_ok = (d_band >= 0) & (d_band < WINDOW) & (blk * BLK + j >= 2 * BLK)
    bias_band = rel_bias[t5_bucket(d_band)].astype(jnp.float32).transpose(2, 0, 1).reshape(G, R, 1, BLK, 2 * BLK)
    m = jnp.arange(N_META)[None, None, :]
    d_meta = blk * BLK + i - pad - m
    meta_ok = d_meta >= 0
    bias_meta = rel_bias[t5_bucket(d_meta)].astype(jnp.float32).transpose(3, 0, 1, 2).reshape(G, R, nb, BLK, N_META)

    sink = jnp.broadcast_to(sinks.astype(jnp.float32).reshape(1, G, R, 1, 1, 1), s_band.shape[:-1] + (1,))
    logits = jnp.concatenate([
        jnp.where(band_ok, s_band + bias_band, NEG),
        jnp.where(meta_ok, s_meta + bias_meta, NEG),
        sink], axis=-1)
    probs = jax.nn.softmax(logits, axis=-1).astype(v.dtype)
    out = (jnp.einsum('bgrnqk,bnkgd->bnqgrd', probs[..., :2 * BLK], v_band)
           + jnp.einsum('bgrnqm,bmgd->bnqgrd', probs[..., 2 * BLK:2 * BLK + N_META], v_meta))
    return out.reshape(Bsz, nb * BLK, ATT_Q)[:, pad:]


def ssd_chunked(X, dA, Bm, Cm):
    Bsz, L = X.shape[0], X.shape[1]
    C, G, R = SSD_CHUNK, SSD_GROUPS, SSD_HEADS // SSD_GROUPS
    pad = C - N_META
    nc = (L + pad) // C

    def chunks(t):
        t = jnp.pad(t, [(0, 0), (pad, 0)] + [(0, 0)] * (t.ndim - 2))
        return t.reshape((Bsz, nc, C) + t.shape[2:])

    Xc = chunks(X).reshape(Bsz, nc, C, G, R, SSD_HEAD_DIM)
    Bc, Cc = chunks(Bm), chunks(Cm)
    Acs = jnp.cumsum(chunks(dA).reshape(Bsz, nc, C, G, R), axis=2)

    tril = jnp.tril(jnp.ones((C, C), dtype=bool))[:, :, None, None]
    seg = Acs[:, :, :, None] - Acs[:, :, None, :]
    Lmat = masked_exp(tril, seg).astype(X.dtype)
    CB = jnp.einsum('bclgn,bcsgn->bclsg', Cc, Bc)
    y_diag = jnp.einsum('bclsgr,bcsgrp->bclgrp', CB[..., None] * Lmat, Xc)

    decay_to_end = jnp.exp(Acs[:, :, -1:] - Acs).astype(X.dtype)
    chunk_states = jnp.einsum('bcsgn,bcsgrp->bcgrpn', Bc, decay_to_end[..., None] * Xc)
    chunk_decay = jnp.exp(Acs[:, :, -1]).astype(X.dtype)

    def step(state, inp):
        s_c, d_c = inp
        return state * d_c[..., None, None] + s_c, state

    _, prev_states = lax.scan(step, jnp.zeros_like(chunk_states[:, 0]),
                              (jnp.moveaxis(chunk_states, 1, 0), jnp.moveaxis(chunk_decay, 1, 0)))
    prev_states = jnp.moveaxis(prev_states, 0, 1)
    y_off = jnp.einsum('bclgn,bcgrpn->bclgrp', Cc, prev_states) * jnp.exp(Acs).astype(X.dtype)[..., None]
    return (y_diag + y_off).reshape(Bsz, nc * C, SSD_HEADS, SSD_HEAD_DIM)[:, pad:]


def ssd_mixer(z, xbc, dt_raw, conv_w, conv_b, dt_bias, a_log, d_skip, norm_w):
    Bsz, L = z.shape[0], z.shape[1]
    xbc = jax.nn.silu(causal_dwconv(xbc, conv_w, conv_b))
    xs, Bm, Cm = jnp.split(xbc, [SSD_INNER, SSD_INNER + SSD_GROUPS * SSD_STATE], axis=-1)
    xs = xs.reshape(Bsz, L, SSD_HEADS, SSD_HEAD_DIM)
    Bm = Bm.reshape(Bsz, L, SSD_GROUPS, SSD_STATE)
    Cm = Cm.reshape(Bsz, L, SSD_GROUPS, SSD_STATE)
    dt = jax.nn.softplus(dt_raw.astype(jnp.float32) + dt_bias.astype(jnp.float32))
    dA = dt * (-jnp.exp(a_log.astype(jnp.float32)))
    y = ssd_chunked(xs * dt[..., None].astype(xs.dtype), dA, Bm, Cm) + xs * d_skip.astype(xs.dtype)[:, None]
    gz = (y.reshape(Bsz, L, SSD_INNER) * jax.nn.silu(z)).reshape(Bsz, L, SSD_GROUPS, SSD_INNER // SSD_GROUPS)
    return rmsnorm(gz, norm_w.reshape(SSD_GROUPS, SSD_INNER // SSD_GROUPS)).reshape(Bsz, L, SSD_INNER)


def hgrn2_mixer(q, f_raw, i_in, g, lb, norm_w):
    Bsz, L = q.shape[0], q.shape[1]
    H, C = HG_HEADS, HG_CHUNK
    nc = L // C
    lbf = lb.astype(jnp.float32)
    ff = f_raw.astype(jnp.float32)
    log_f = jnp.log(lbf + (1.0 - lbf) * jax.nn.sigmoid(ff))
    k = ((1.0 - lbf) * jax.nn.sigmoid(-ff)).astype(q.dtype)
    q = jax.nn.silu(q)

    def chunks(t, dh):
        return t.reshape(Bsz, nc, C, H, dh).transpose(1, 0, 3, 2, 4)

    tril = jnp.tril(jnp.ones((C, C), dtype=bool))[None, None, :, :, None]

    def step(S, inp):
        qc, kc, vc, lfc = inp
        b = jnp.cumsum(lfc, axis=2)
        rel = masked_exp(tril, b[:, :, :, None, :] - b[:, :, None, :, :]).astype(qc.dtype)
        att = jnp.einsum('bhtsd,bhsd->bhts', qc[:, :, :, None, :] * rel, kc)
        b_end = b[:, :, -1:, :]
        o = (jnp.einsum('bhts,bhsv->bhtv', att, vc)
             + jnp.einsum('bhtd,bhdv->bhtv', qc * jnp.exp(b).astype(qc.dtype), S))
        S = (S * jnp.exp(b_end[:, :, 0, :, None]).astype(S.dtype)
             + jnp.einsum('bhsd,bhsv->bhdv', kc * jnp.exp(b_end - b).astype(kc.dtype), vc))
        return S, o

    S0 = jnp.zeros((Bsz, H, HG_KEY_DIM, HG_VAL_DIM), q.dtype)
    _, o = lax.scan(step, S0, (chunks(q, HG_KEY_DIM), chunks(k, HG_KEY_DIM),
                               chunks(i_in, HG_VAL_DIM), chunks(log_f, HG_KEY_DIM)))
    o = o.transpose(1, 0, 3, 2, 4).reshape(Bsz, L, H, HG_VAL_DIM)
    o = rmsnorm(o, norm_w) * jax.nn.silu(g).reshape(Bsz, L, H, HG_VAL_DIM)
    return o.reshape(Bsz, L, HG_V)


def setup_inputs(seed: int = 0) -> dict:
    key = jax.random.key(seed)
    ks = jax.random.split(key, 24)

    def nrm(k, shape, scale):
        return jax.random.normal(k, shape, jnp.float32) * scale

    dt0 = jnp.exp(jax.random.uniform(ks[9], (DEPTH, SSD_HEADS), jnp.float32,
                                     minval=math.log(1e-3), maxval=math.log(1e-1)))
    return {
        "x": nrm(ks[0], (BATCH, SEQ, D_MODEL), 1.0),
        "meta_tokens": nrm(ks[1], (N_META, D_MODEL), 1.0),
        "rel_bias": nrm(ks[2], (N_BUCKETS, ATT_HEADS), 0.5),
        "lb_logits": nrm(ks[3], (DEPTH, HG_K), 1.0),
        "attn_norm_w": 1.0 + nrm(ks[4], (DEPTH, D_MODEL), 0.02),
        "w_in": nrm(ks[5], (DEPTH, D_MODEL, D_IN), D_MODEL ** -0.5),
        "att_sinks": nrm(ks[6], (DEPTH, ATT_HEADS), 1.0),
        "ssd_conv_w": nrm(ks[7], (DEPTH, SSD_CONV, SSD_XBC), SSD_CONV ** -0.5),
        "ssd_conv_b": nrm(ks[8], (DEPTH, SSD_XBC), 0.02),
        "ssd_dt_bias": dt0 + jnp.log(-jnp.expm1(-dt0)),
        "ssd_a_log": jnp.log(jax.random.uniform(ks[10], (DEPTH, SSD_HEADS), jnp.float32, minval=1.0, maxval=16.0)),
        "ssd_d": 1.0 + nrm(ks[11], (DEPTH, SSD_HEADS), 0.1),
        "ssd_norm_w": 1.0 + nrm(ks[12], (DEPTH, SSD_INNER), 0.02),
        "hg_norm_w": 1.0 + nrm(ks[13], (DEPTH, HG_VAL_DIM), 0.02),
        "w_branch": nrm(ks[14], (DEPTH, N_BRANCH, BRANCH_WIDTH, D_MODEL), BRANCH_WIDTH ** -0.5),
        "w_out": nrm(ks[15], (DEPTH, D_MODEL, D_MODEL), D_MODEL ** -0.5),
        "ffn_norm_w": 1.0 + nrm(ks[16], (DEPTH, D_MODEL), 0.02),
        "w_up": nrm(ks[17], (DEPTH, D_MODEL, 2 * D_FF), D_MODEL ** -0.5),
        "ffn_conv_w": nrm(ks[18], (DEPTH, FFN_CONV, 2 * D_FF), FFN_CONV ** -0.5),
        "ffn_conv_b": nrm(ks[19], (DEPTH, 2 * D_FF), 0.02),
        "w_down": nrm(ks[20], (DEPTH, D_FF, D_MODEL), D_FF ** -0.5),
        "final_norm_w": 1.0 + nrm(ks[21], (D_MODEL,), 0.02),
    }


def reference(x, meta_tokens, rel_bias, lb_logits, attn_norm_w, w_in, att_sinks, ssd_conv_w, ssd_conv_b,
              ssd_dt_bias, ssd_a_log, ssd_d, ssd_norm_w, hg_norm_w, w_branch, w_out, ffn_norm_w, w_up,
              ffn_conv_w, ffn_conv_b, w_down, final_norm_w):
    Bsz = x.shape[0]
    h = jnp.concatenate([jnp.broadcast_to(meta_tokens.astype(x.dtype)[None], (Bsz, N_META, D_MODEL)), x], axis=1)
    L = h.shape[1]
    lb_p = jax.nn.softmax(lb_logits.astype(jnp.float32), axis=0)
    lower_bounds = jnp.clip(jnp.cumsum(lb_p, axis=0) - lb_p[0], 0.0, 1.0 - 1e-4)
    split_at = np.cumsum(IN_SIZES)[:-1].tolist()

    for l in range(DEPTH):
        u = rmsnorm(h, attn_norm_w[l])
        proj = u @ w_in[l]
        aq, ak, av, sz, sxbc, sdt, hq, hf, hi, hgate, gates = jnp.split(proj, split_at, axis=-1)
        y_att = sliding_window_attention(
            aq.reshape(Bsz, L, ATT_HEADS, ATT_HEAD_DIM),
            ak.reshape(Bsz, L, ATT_KV_HEADS, ATT_HEAD_DIM),
            av.reshape(Bsz, L, ATT_KV_HEADS, ATT_HEAD_DIM),
            att_sinks[l], rel_bias)
        y_ssd = ssd_mixer(sz, sxbc, sdt, ssd_conv_w[l], ssd_conv_b[l], ssd_dt_bias[l], ssd_a_log[l],
                          ssd_d[l], ssd_norm_w[l])
        y_hg = hgrn2_mixer(hq, hf, hi, hgate, lower_bounds[l], hg_norm_w[l])
        branches = jnp.stack([y_att.astype(h.dtype), y_ssd.astype(h.dtype), y_hg.astype(h.dtype)], axis=2)
        branch_d = jnp.einsum('blnc,ncd->blnd', branches, w_branch[l])
        g = jax.nn.sigmoid(gates.astype(jnp.float32)).astype(h.dtype).reshape(Bsz, L, N_BRANCH, D_MODEL)
        merged = jnp.sum(g * branch_d, axis=2)
        h = h + merged @ w_out[l]

        u = rmsnorm(h, ffn_norm_w[l])
        a = causal_dwconv(u @ w_up[l], ffn_conv_w[l], ffn_conv_b[l])
        gate, up = jnp.split(a, 2, axis=-1)
        h = h + (jax.nn.silu(gate) * up) @ w_down[l]

    return rmsnorm(h, final_norm_w)[:, N_META:]
```

```cpp
#include <hip/hip_runtime.h>
#include <hip/hip_cooperative_groups.h>
#include <cstdio>
#include <cstdint>
namespace cg = cooperative_groups;

namespace pg8 {
#define PG8_LAS __attribute__((address_space(3)))
constexpr int WMAP_OFF = 163840 - 16 - 256;
__device__ __forceinline__ int wg_tid(PG8_LAS unsigned char* ldsbase) {
    const unsigned hw = (unsigned)__builtin_amdgcn_s_getreg((5 << 11) | 4) & 63u;
    const unsigned wv = ((volatile PG8_LAS unsigned*)(ldsbase + WMAP_OFF))[hw];
    const int lane = (int)__builtin_amdgcn_mbcnt_hi(~0u, __builtin_amdgcn_mbcnt_lo(~0u, 0u));
    int t = (int)__builtin_amdgcn_readfirstlane(wv) * 64 + lane;
    asm volatile("" : "+v"(t));
    return t;
}
typedef unsigned short bf16_t;
typedef short bf16x8 __attribute__((ext_vector_type(8)));
typedef float f32x4 __attribute__((ext_vector_type(4)));
typedef unsigned u32x4 __attribute__((ext_vector_type(4)));
constexpr int BM = 256, BK = 64, HALF = 128, HTB = HALF * BK * 2, STAGE_BYTES = 8 * HTB, NXCD = 8, WGM = 8;

__host__ __device__ __forceinline__ int lds_byte(int r, int c) { const int st = (r >> 4) * 2 + (c >> 5), rr = r & 15, cc = c & 31, ob = rr * 64 + cc * 2; return st * 1024 + (ob ^ (((ob >> 9) & 1) << 5)); }
__host__ __device__ __forceinline__ void stage_rc(int b, int& R, int& C) { const int st = b / 1024, sb = b % 1024, swz = sb ^ (((sb >> 9) & 1) << 5); R = (st >> 1) * 16 + swz / 64; C = (st & 1) * 32 + (swz % 64) / 2; }
__host__ __device__ __forceinline__ int perm32(int rho) { const int n = rho >> 4, i = rho & 15; return 8 * (i >> 2) + 4 * n + (i & 3); }

struct Unit { int pm, pn, sel, lpm; };
struct Gemm { const bf16_t* A; const bf16_t* Bt; int K, lda, alocal; size_t asel, bsel; };

struct Sched {
    int nM, nN, nsel, G, c, pm0, nMain;
    __device__ __forceinline__ bool next(int i, Unit& u) const {
        const int nwg = nM * nN; const int L = (i / nsel) * G + c; if (L >= nwg) return false;
        int wgid = L; { const int q = nwg / NXCD, r = nwg % NXCD, xcd = wgid % NXCD, off = wgid / NXCD; wgid = (xcd < r ? xcd * (q + 1) : r * (q + 1) + (xcd - r) * q) + off; }
        const int nig = WGM * nN, gid = wgid / nig, fm = gid * WGM, gsz = (nM - fm) < WGM ? (nM - fm) : WGM;
        u.lpm = fm + ((wgid % nig) % gsz); u.pn = (wgid % nig) / gsz; u.sel = i % nsel; u.pm = (u.lpm < nMain) ? (pm0 + u.lpm) : 128; return true;
    }
    __device__ __forceinline__ void a_ready(const Unit&) const {}
    __device__ __forceinline__ void done(const Unit&) const {}
};
typedef float f32x2_t __attribute__((ext_vector_type(2))); typedef __bf16 bf16x2_t __attribute__((ext_vector_type(2)));
__device__ __forceinline__ unsigned pk2_(float lo, float hi) { f32x2_t v = {lo, hi}; bf16x2_t b = __builtin_convertvector(v, bf16x2_t); return __builtin_bit_cast(unsigned, b); }
__device__ __forceinline__ float bflo(unsigned w) { return __builtin_bit_cast(float, w << 16); }
__device__ __forceinline__ float bfhi(unsigned w) { return __builtin_bit_cast(float, w & 0xffff0000u); }
__device__ __forceinline__ float sigm(float x) { return __builtin_amdgcn_rcpf(1.0f + __expf(-x)); }

template <int ACT  > struct EpiStore {
    static constexpr bool PERM = true, AFTER_DRAIN = false;
    bf16_t* O; int ldc; int local;
    __device__ __forceinline__ void operator()(const f32x4 (&acc)[2][2][4][2], const Unit& u, int wr, int wc, int fr, int fq) const {
        const int row0 = (local ? u.lpm : u.pm) * BM + wr * 64 + fr; const int col0 = u.pn * BM + wc * 32 + 8 * fq;
#pragma unroll
        for (int ai = 0; ai < 2; ++ai)
#pragma unroll
            for (int m = 0; m < 4; ++m) { bf16_t* rowp = O + (size_t)(row0 + ai * HALF + m * 16) * ldc + col0;
#pragma unroll
                for (int bj = 0; bj < 2; ++bj) { f32x4 v0 = acc[ai][bj][m][0], v1 = acc[ai][bj][m][1];
                    if (ACT == 1) { v0 = (f32x4){sigm(v0[0]), sigm(v0[1]), sigm(v0[2]), sigm(v0[3])}; v1 = (f32x4){sigm(v1[0]), sigm(v1[1]), sigm(v1[2]), sigm(v1[3])}; }
                    u32x4 w; w.x = pk2_(v0[0], v0[1]); w.y = pk2_(v0[2], v0[3]); w.z = pk2_(v1[0], v1[1]); w.w = pk2_(v1[2], v1[3]);
                    *(u32x4*)(rowp + bj * HALF) = w; } }
    }
};
struct GateMap { bf16_t* PJg; bf16_t* Xa; bf16_t* Xb;
    __device__ __forceinline__ bf16_t* at(int pm, int rl, int gt  , int c) const {
        if (gt < 12) return PJg + (size_t)(pm * BM + rl) * 8448 + gt * BM + c;
        return (pm < 64 ? Xa + (size_t)(pm * BM + rl) * 3072 : Xb + (size_t)((pm - 64) * BM + rl) * 3072) + (gt - 12) * BM + c; } };
struct EpiGate {
    static constexpr bool PERM = true, AFTER_DRAIN = false;
    GateMap gm;
    __device__ __forceinline__ void operator()(const f32x4 (&acc)[2][2][4][2], const Unit& u, int wr, int wc, int fr, int fq) const {
        const int c0 = wc * 32 + 8 * fq;
#pragma unroll
        for (int ai = 0; ai < 2; ++ai)
#pragma unroll
            for (int m = 0; m < 4; ++m) { bf16_t* rowp = gm.at(u.pm, wr * 64 + fr + ai * HALF + m * 16, u.pn, c0);
#pragma unroll
                for (int bj = 0; bj < 2; ++bj) { const f32x4 v0 = acc[ai][bj][m][0], v1 = acc[ai][bj][m][1];
                    u32x4 w; w.x = pk2_(sigm(v0[0]), sigm(v0[1])); w.y = pk2_(sigm(v0[2]), sigm(v0[3])); w.z = pk2_(sigm(v1[0]), sigm(v1[1])); w.w = pk2_(sigm(v1[2]), sigm(v1[3]));
                    *(u32x4*)(rowp + bj * HALF) = w; } }
    }
};
struct EpiMerge {
    static constexpr bool PERM = true, AFTER_DRAIN = false;
    GateMap gm; bf16_t* Mg; int ldm;
    __device__ __forceinline__ void operator()(const f32x4 (&acc)[2][2][4][2], const Unit& u, int wr, int wc, int fr, int fq) const {
        const int col0 = u.pn * BM + wc * 32 + 8 * fq;
#pragma unroll
        for (int ai = 0; ai < 2; ++ai) {
            u32x4 gw[4][2], ow[4][2];
#pragma unroll
            for (int m = 0; m < 4; ++m) { const int rl = wr * 64 + fr + ai * HALF + m * 16;
                const bf16_t* gp = gm.at(u.pm, rl, u.sel * 8 + u.pn, wc * 32 + 8 * fq); const bf16_t* mp2 = Mg + (size_t)(u.pm * BM + rl) * ldm + col0;
#pragma unroll
                for (int bj = 0; bj < 2; ++bj) { gw[m][bj] = *(const u32x4*)(gp + bj * HALF); ow[m][bj] = (u32x4){0u, 0u, 0u, 0u}; if (u.sel > 0) ow[m][bj] = *(const u32x4*)(mp2 + bj * HALF); } }
#pragma unroll
            for (int m = 0; m < 4; ++m) { const int rl = wr * 64 + fr + ai * HALF + m * 16; bf16_t* mp2 = Mg + (size_t)(u.pm * BM + rl) * ldm + col0;
#pragma unroll
                for (int bj = 0; bj < 2; ++bj) { const f32x4 v0 = acc[ai][bj][m][0], v1 = acc[ai][bj][m][1]; const u32x4 g = gw[m][bj], o = ow[m][bj];
                    u32x4 w; w.x = pk2_(bflo(o.x) + bflo(g.x) * v0[0], bfhi(o.x) + bfhi(g.x) * v0[1]); w.y = pk2_(bflo(o.y) + bflo(g.y) * v0[2], bfhi(o.y) + bfhi(g.y) * v0[3]);
                    w.z = pk2_(bflo(o.z) + bflo(g.z) * v1[0], bfhi(o.z) + bfhi(g.z) * v1[1]); w.w = pk2_(bflo(o.w) + bflo(g.w) * v1[2], bfhi(o.w) + bfhi(g.w) * v1[3]);
                    *(u32x4*)(mp2 + bj * HALF) = w; } }
            asm volatile("" ::: "memory");
        }
    }
};
struct EpiResid {
    static constexpr bool PERM = false, AFTER_DRAIN = false;
    bf16_t* H;
    __device__ __forceinline__ void operator()(const f32x4 (&acc)[2][2][4][2], const Unit& u, int wr, int wc, int fr, int fq) const {
        typedef unsigned u32x2_ __attribute__((ext_vector_type(2)));
        const int col0 = u.pn * BM + wc * 32 + 4 * fq;
#pragma unroll
        for (int ai = 0; ai < 2; ++ai) {
            u32x2_ v[4][2][2];
#pragma unroll
            for (int m = 0; m < 4; ++m) { const bf16_t* rowp = H + (size_t)(u.pm * BM + wr * 64 + fr + ai * HALF + m * 16) * 2048 + col0;
#pragma unroll
                for (int bj = 0; bj < 2; ++bj)
#pragma unroll
                    for (int n = 0; n < 2; ++n) v[m][bj][n] = *(const u32x2_*)(rowp + bj * HALF + n * 16); }
#pragma unroll
            for (int m = 0; m < 4; ++m) { bf16_t* rowp = H + (size_t)(u.pm * BM + wr * 64 + fr + ai * HALF + m * 16) * 2048 + col0;
#pragma unroll
                for (int bj = 0; bj < 2; ++bj)
#pragma unroll
                    for (int n = 0; n < 2; ++n) { const f32x4 a = acc[ai][bj][m][n]; const u32x2_ o = v[m][bj][n];
                        u32x2_ w; w.x = pk2_(bflo(o.x) + a[0], bfhi(o.x) + a[1]); w.y = pk2_(bflo(o.y) + a[2], bfhi(o.y) + a[3]); *(u32x2_*)(rowp + bj * HALF + n * 16) = w; } }
            asm volatile("" ::: "memory");
        }
    }
};

template <class Epi, class Sched, bool ALIGN_EPI = false, bool SP2 = false>
__device__ __forceinline__ void gemm_phase(PG8_LAS unsigned char* lds, const Gemm g, const Sched& S, const Epi& E) {
    const int tid0_ = wg_tid(lds);
    const int tid = tid0_, wid = __builtin_amdgcn_readfirstlane(tid >> 6), lane = tid & 63, wr = wid >> 2, wc = wid & 3, fr = lane & 15, fq = lane >> 4;
    const int K = g.K, nt = K / BK, lda = g.lda;
    unsigned voffA[2], voffB[2];
#pragma unroll
    for (int i = 0; i < 2; ++i) { int R, C; stage_rc(tid * 16 + i * 8192, R, C); const int Rb = Epi::PERM ? ((R & ~31) + perm32(R & 31)) : R;
        voffA[i] = (unsigned)(R * lda + C) * 2u; voffB[i] = (unsigned)(Rb * K + C) * 2u; }
    const size_t kstep = (size_t)(BK * 2);
    const size_t hstepA = (size_t)HALF * lda * 2, hstepB = (size_t)HALF * K * 2;
    const unsigned ldsw = (unsigned)wid * 1024u;
    const int aoff = lds_byte(wr * 64 + fr, fq * 8), boff = lds_byte(wc * 32 + fr, fq * 8);
#define PG8_SA(b, h) (((b) * 2 + (h)) * HTB)
#define PG8_SB(b, h) ((4 + (b) * 2 + (h)) * HTB)
#define PG8_STAGE(bufoff, gbase, voff) do { _Pragma("unroll") for (int _i = 0; _i < 2; ++_i) \
        __builtin_amdgcn_global_load_lds((const unsigned*)((const char*)(gbase) + (voff)[_i]), (PG8_LAS unsigned*)(lds + (bufoff) + ldsw + _i * 8192), 16, 0, 0); } while (0)
#define PG8_LDA(dst, b, h) do { _Pragma("unroll") for (int m = 0; m < 4; ++m) _Pragma("unroll") for (int k = 0; k < 2; ++k) dst[m][k] = *(const PG8_LAS bf16x8*)(lds + PG8_SA(b, h) + aoff + m * 2048 + k * 1024); } while (0)
#define PG8_LDB(dst, b, h) do { _Pragma("unroll") for (int n = 0; n < 2; ++n) _Pragma("unroll") for (int k = 0; k < 2; ++k) dst[n][k] = *(const PG8_LAS bf16x8*)(lds + PG8_SB(b, h) + boff + n * 2048 + k * 1024); } while (0)
#define PG8_MMA(ai, bj, At, Bt) do { __builtin_amdgcn_s_setprio(1); _Pragma("unroll") for (int m = 0; m < 4; ++m) _Pragma("unroll") for (int n = 0; n < 2; ++n) _Pragma("unroll") for (int k = 0; k < 2; ++k) \
        acc[ai][bj][m][n] = __builtin_amdgcn_mfma_f32_16x16x32_bf16(Bt[n][k], At[m][k], acc[ai][bj][m][n], 0, 0, 0); __builtin_amdgcn_s_setprio(0); } while (0)
#define PG8_WAIT_V(n) asm volatile("s_waitcnt vmcnt(" #n ")" ::: "memory")
#define PG8_WAIT_L(n) asm volatile("s_waitcnt lgkmcnt(" #n ")" ::: "memory")
#define PG8_BAR __builtin_amdgcn_s_barrier()
#define PG8_SCHED __builtin_amdgcn_sched_barrier(0)
#define PG8_UA(u) ((const char*)g.A + ((size_t)(g.alocal ? (u).lpm : (u).pm) * 256 * (size_t)lda + (size_t)(u).sel * g.asel) * 2)
#define PG8_UB(u) ((const char*)g.Bt + ((size_t)(u).pn * 256 * (size_t)K + (size_t)(u).sel * g.bsel) * 2)
    Unit cur, nxt; int ui = 0;
    if (!S.next(0, cur)) return;
    f32x4 acc[2][2][4][2];
#pragma unroll
    for (int a = 0; a < 2; ++a)
#pragma unroll
        for (int b = 0; b < 2; ++b)
#pragma unroll
            for (int m = 0; m < 4; ++m)
#pragma unroll
                for (int n = 0; n < 2; ++n) acc[a][b][m][n] = (f32x4){0.f, 0.f, 0.f, 0.f};
    bf16x8 At[4][2], B0[2][2], B1[2][2];
    const char* cA = PG8_UA(cur); const char* cB = PG8_UB(cur);
    S.a_ready(cur);
    if constexpr (SP2) {
        PG8_STAGE(PG8_SB(0, 0), cB, voffB); PG8_STAGE(PG8_SB(0, 1), cB + hstepB, voffB); PG8_STAGE(PG8_SA(0, 0), cA, voffA); PG8_STAGE(PG8_SA(0, 1), cA + hstepA, voffA);
        if (wr == 1) PG8_BAR;
        PG8_WAIT_V(2); PG8_BAR;
        PG8_STAGE(PG8_SB(1, 0), cB + kstep, voffB); PG8_STAGE(PG8_SA(1, 0), cA + kstep, voffA); PG8_STAGE(PG8_SB(1, 1), cB + hstepB + kstep, voffB);
        PG8_WAIT_V(6); PG8_BAR;
    } else {
        PG8_STAGE(PG8_SB(0, 0), cB, voffB); PG8_STAGE(PG8_SA(0, 0), cA, voffA); PG8_STAGE(PG8_SB(0, 1), cB + hstepB, voffB); PG8_STAGE(PG8_SA(0, 1), cA + hstepA, voffA);
        if (wr == 1) PG8_BAR;
        PG8_WAIT_V(4); PG8_BAR;
        PG8_STAGE(PG8_SB(1, 0), cB + kstep, voffB); PG8_STAGE(PG8_SA(1, 0), cA + kstep, voffA); PG8_STAGE(PG8_SB(1, 1), cB + hstepB + kstep, voffB);
        PG8_WAIT_V(6); PG8_BAR;
    }
    for (;;) {
        const bool has_next = S.next(ui + 1, nxt);
        const char* nA = has_next ? PG8_UA(nxt) : cA; const char* nB = has_next ? PG8_UB(nxt) : cB;
        for (int t = 0; t < nt; t += 2) {
            const bool last = (t == nt - 2);
            const char* a1 = cA + (size_t)(t + 1) * kstep;
            const char* a2 = last ? nA : cA + (size_t)(t + 2) * kstep; const char* b2 = last ? nB : cB + (size_t)(t + 2) * kstep;
            const char* a3 = a2 + kstep; const char* b3 = b2 + kstep;
            if (last && has_next) S.a_ready(nxt);
            if constexpr (SP2) {
            PG8_LDB(B0, 0, 0); PG8_LDB(B1, 0, 1); PG8_SCHED; PG8_LDA(At, 0, 0); PG8_STAGE(PG8_SA(1, 1), a1 + hstepA, voffA);
            PG8_WAIT_V(8); PG8_WAIT_L(0); PG8_BAR; PG8_MMA(0, 0, At, B0); PG8_MMA(0, 1, At, B1); PG8_BAR; PG8_SCHED;
            PG8_LDA(At, 0, 1); PG8_STAGE(PG8_SB(0, 0), b2, voffB); PG8_STAGE(PG8_SB(0, 1), b2 + hstepB, voffB); PG8_STAGE(PG8_SA(0, 0), a2, voffA);
            PG8_WAIT_V(8); PG8_WAIT_L(0); PG8_BAR; PG8_MMA(1, 0, At, B0); PG8_MMA(1, 1, At, B1); PG8_BAR; PG8_SCHED;
            PG8_LDB(B0, 1, 0); PG8_LDB(B1, 1, 1); PG8_SCHED; PG8_LDA(At, 1, 0); PG8_STAGE(PG8_SA(0, 1), a2 + hstepA, voffA);
            PG8_WAIT_V(8); PG8_WAIT_L(0); PG8_BAR; PG8_MMA(0, 0, At, B0); PG8_MMA(0, 1, At, B1); PG8_BAR; PG8_SCHED;
            PG8_LDA(At, 1, 1); PG8_STAGE(PG8_SB(1, 0), b3, voffB); PG8_STAGE(PG8_SB(1, 1), b3 + hstepB, voffB); PG8_STAGE(PG8_SA(1, 0), a3, voffA);
            PG8_WAIT_V(8); PG8_WAIT_L(0); PG8_BAR; PG8_MMA(1, 0, At, B0); PG8_MMA(1, 1, At, B1); PG8_BAR; PG8_SCHED;
            } else {
            PG8_LDB(B0, 0, 0); PG8_SCHED; PG8_LDA(At, 0, 0); PG8_STAGE(PG8_SA(1, 1), a1 + hstepA, voffA);
            PG8_WAIT_L(8); PG8_BAR; PG8_WAIT_L(0); PG8_MMA(0, 0, At, B0); PG8_BAR; PG8_SCHED;
            PG8_LDB(B1, 0, 1); PG8_STAGE(PG8_SB(0, 0), b2, voffB);
            PG8_BAR; PG8_WAIT_L(0); PG8_MMA(0, 1, At, B1); PG8_BAR;
            PG8_LDA(At, 0, 1); PG8_STAGE(PG8_SA(0, 0), a2, voffA);
            PG8_BAR; PG8_WAIT_L(0); PG8_MMA(1, 0, At, B0); PG8_BAR; PG8_SCHED;
            PG8_STAGE(PG8_SB(0, 1), b2 + hstepB, voffB);
            PG8_WAIT_V(6); PG8_BAR; PG8_MMA(1, 1, At, B1); PG8_BAR;
            PG8_LDB(B0, 1, 0); PG8_SCHED; PG8_LDA(At, 1, 0); PG8_STAGE(PG8_SA(0, 1), a2 + hstepA, voffA);
            PG8_WAIT_L(8); PG8_BAR; PG8_WAIT_L(0); PG8_MMA(0, 0, At, B0); PG8_BAR; PG8_SCHED;
            PG8_LDB(B1, 1, 1); PG8_STAGE(PG8_SB(1, 0), b3, voffB);
            PG8_BAR; PG8_WAIT_L(0); PG8_MMA(0, 1, At, B1); PG8_BAR;
            PG8_LDA(At, 1, 1); PG8_STAGE(PG8_SA(1, 0), a3, voffA);
            PG8_BAR; PG8_WAIT_L(0); PG8_MMA(1, 0, At, B0); PG8_BAR; PG8_SCHED;
            PG8_STAGE(PG8_SB(1, 1), b3 + hstepB, voffB);
            PG8_WAIT_V(6); PG8_BAR; PG8_MMA(1, 1, At, B1); PG8_BAR;
            }
        }
        if constexpr (ALIGN_EPI) { if (wr == 0) PG8_BAR; }
        if constexpr (!Epi::AFTER_DRAIN) { E(acc, cur, wr, wc, fr, fq); S.done(cur); }
        if (!has_next) break;
#pragma unroll
        for (int a = 0; a < 2; ++a)
#pragma unroll
            for (int b = 0; b < 2; ++b)
#pragma unroll
                for (int m = 0; m < 4; ++m)
#pragma unroll
                    for (int n = 0; n < 2; ++n) acc[a][b][m][n] = (f32x4){0.f, 0.f, 0.f, 0.f};
        cur = nxt; cA = nA; cB = nB; ++ui;
        if constexpr (ALIGN_EPI) { if (wr == 1) PG8_BAR; }
    }
    PG8_WAIT_V(0);
    if constexpr (!ALIGN_EPI) { if (wr == 0) PG8_BAR; }
    PG8_BAR;
    if constexpr (Epi::AFTER_DRAIN) { E.fused(acc, cur, wr, wc, fr, fq, lds, wid, lane); S.done(cur); }
#undef PG8_SA
#undef PG8_SB
#undef PG8_STAGE
#undef PG8_LDA
#undef PG8_LDB
#undef PG8_MMA
#undef PG8_WAIT_V
#undef PG8_WAIT_L
#undef PG8_BAR
#undef PG8_SCHED
#undef PG8_UA
#undef PG8_UB
}
}

typedef unsigned short bf16_t;
typedef short bf16x8 __attribute__((ext_vector_type(8)));
typedef short bf16x4 __attribute__((ext_vector_type(4)));
typedef float f32x4 __attribute__((ext_vector_type(4)));
typedef unsigned u32x4 __attribute__((ext_vector_type(4)));
typedef unsigned u32x2 __attribute__((ext_vector_type(2)));
#define LAS __attribute__((address_space(3)))

constexpr int DM = 2048, NB = 2, SEQ = 16384, NMETA = 16, MMAIN = NB * SEQ, MTOK = MMAIN + NB * NMETA, MPAD = 33024;
constexpr int DIN = 14608, DFF = 5632, PW = 8448;
constexpr int C_AQ = 0, C_SZ = 1024, C_HG = 2048, C_AK = 3072, C_AV = 3200, C_XBC = 3328, C_HQ = 5376, C_HF = 6400, C_HI = 7424;
constexpr int NCH = 129;
constexpr float EPS = 1e-6f, NEGV = -1e30f;
constexpr size_t MiB = 1u << 20;
constexpr size_t WS_H = 1 * MiB, WS_U = 259 * MiB, WS_R = 388 * MiB, WS_X = 921 * MiB, WS_NEED = 1024 * MiB;
constexpr size_t DO_WIN = 0, DO_WG = 33 * MiB, DO_WB = 57 * MiB, DO_WO = 69 * MiB, DO_WUP = 77 * MiB, DO_WD = 121 * MiB, DO_WDT = 143 * MiB,
                 DO_HGS = 144 * MiB, DO_HGDEC = 209 * MiB, DO_DTRAW = 211 * MiB, DO_SSDDEC = 214 * MiB,
                 DO_GB = 144 * MiB  , DO_GMETA = 242 * MiB;
constexpr int LDS_BYTES = 163840, NGRID = 256;

__device__ __forceinline__ float bf2f(bf16_t v) { return __builtin_bit_cast(float, (unsigned)v << 16); }
typedef float f32x2_t __attribute__((ext_vector_type(2))); typedef __bf16 bf16x2_t __attribute__((ext_vector_type(2)));
__device__ __forceinline__ unsigned pk2(float lo, float hi) { f32x2_t v = {lo, hi}; bf16x2_t b = __builtin_convertvector(v, bf16x2_t); return __builtin_bit_cast(unsigned, b); }
__device__ __forceinline__ unsigned f2bf(float f) { return pk2(f, 0.f) & 0xffffu; }
__device__ __forceinline__ float bflo(unsigned w) { return __builtin_bit_cast(float, w << 16); }
__device__ __forceinline__ float bfhi(unsigned w) { return __builtin_bit_cast(float, w & 0xffff0000u); }
__device__ __forceinline__ float sigm(float x) { return __builtin_amdgcn_rcpf(1.0f + __expf(-x)); }
__device__ __forceinline__ float siluf(float x) { return x * __builtin_amdgcn_rcpf(1.0f + __expf(-x)); }
__device__ __forceinline__ int tok_row(int b, int t) { return t < NMETA ? (MMAIN + b * NMETA + t) : (b * SEQ + t - NMETA); }
__device__ __forceinline__ float shx(float v, int o, int lane) { return __builtin_bit_cast(float, __builtin_amdgcn_ds_bpermute((lane ^ o) << 2, __builtin_bit_cast(int, v))); }
__device__ __forceinline__ float wave_sum(float v, int lane) {
#pragma unroll
    for (int o = 1; o < 64; o <<= 1) v += shx(v, o, lane);
    return v;
}
__device__ __forceinline__ void unpack8(const u32x4 w, float* f) { f[0] = bflo(w.x); f[1] = bfhi(w.x); f[2] = bflo(w.y); f[3] = bfhi(w.y); f[4] = bflo(w.z); f[5] = bfhi(w.z); f[6] = bflo(w.w); f[7] = bfhi(w.w); }
__device__ __forceinline__ f32x4 mfma32(bf16x8 a, bf16x8 b, f32x4 c) { return __builtin_amdgcn_mfma_f32_16x16x32_bf16(a, b, c, 0, 0, 0); }
__device__ __forceinline__ f32x4 mfma16(bf16x4 a, bf16x4 b, f32x4 c) { return __builtin_amdgcn_mfma_f32_16x16x16bf16_1k(a, b, c, 0, 0, 0); }
__device__ __forceinline__ bf16x4 pack4(f32x4 v) { u32x2 w; w.x = pk2(v[0], v[1]); w.y = pk2(v[2], v[3]); return __builtin_bit_cast(bf16x4, w); }
__device__ __forceinline__ bf16x8 pack8(f32x4 a, f32x4 b) { u32x4 w; w.x = pk2(a[0], a[1]); w.y = pk2(a[2], a[3]); w.z = pk2(b[0], b[1]); w.w = pk2(b[2], b[3]); return __builtin_bit_cast(bf16x8, w); }
__device__ __forceinline__ bf16x8 cat8(u32x2 lo, u32x2 hi) { u32x4 w; w.x = lo.x; w.y = lo.y; w.z = hi.x; w.w = hi.y; return __builtin_bit_cast(bf16x8, w); }

struct Ptrs {
    const float *x, *meta, *rel_bias, *lb_logits, *attn_norm_w, *w_in, *att_sinks, *ssd_conv_w, *ssd_conv_b, *ssd_dt_bias, *ssd_a_log, *ssd_d, *ssd_norm_w,
        *hg_norm_w, *w_branch, *w_out, *ffn_norm_w, *w_up, *ffn_conv_w, *ffn_conv_b, *w_down, *final_norm_w;
    float* out; unsigned char* ws;
};

__device__ __forceinline__ int win_srccol(int r0) {
    return r0 < 1024 ? r0 : r0 < 2048 ? 1280 + (r0 - 1024) : r0 < 3072 ? 7440 + (r0 - 2048) : r0 < 3200 ? 1024 + (r0 - 3072) : r0 < 3328 ? 1152 + (r0 - 3200)
         : r0 < 5376 ? 2304 + (r0 - 3328) : r0 < 6400 ? 4368 + (r0 - 5376) : r0 < 7424 ? 5392 + (r0 - 6400) : 6416 + (r0 - 7424);
}
__device__ __forceinline__ void convert_weights(const Ptrs& P, int l, unsigned char* lds, int gw, int NGW, int lane, int wave) {
    float* scr = (float*)(lds + wave * 16384);
    unsigned char* dob = (unsigned char*)P.out;
    const float* win = P.w_in + (size_t)l * DM * DIN;
#define CONV_DECODE(it) \
            const float* W; bf16_t* WT; int ld, col, K, kb; \
            if (it < 8448) { kb = it & 31; const int r0 = 32 * (it >> 5); W = win; ld = DIN; col = win_srccol(r0); K = DM; WT = (bf16_t*)(dob + DO_WIN) + (size_t)r0 * DM; } \
            else if (it < 14592) { const int i2 = it - 8448; kb = i2 & 31; const int r0 = 32 * (i2 >> 5); W = win; ld = DIN; col = 8464 + r0; K = DM; WT = (bf16_t*)(dob + DO_WG) + (size_t)r0 * DM; } \
            else if (it < 17664) { const int i2 = it - 14592, n = i2 >> 10, i3 = i2 & 1023; kb = i3 & 15; const int r0 = 32 * (i3 >> 4); W = P.w_branch + ((size_t)l * 3 + n) * 1024 * DM; ld = DM; col = r0; K = 1024; \
                WT = (bf16_t*)(dob + DO_WB) + (size_t)n * DM * 1024 + (size_t)r0 * 1024; } \
            else if (it < 19712) { const int i2 = it - 17664; kb = i2 & 31; const int r0 = 32 * (i2 >> 5); W = P.w_out + (size_t)l * DM * DM; ld = DM; col = r0; K = DM; WT = (bf16_t*)(dob + DO_WO) + (size_t)r0 * DM; } \
            else if (it < 30976) { const int i2 = it - 19712; kb = i2 & 31; const int r0 = 32 * (i2 >> 5); W = P.w_up + (size_t)l * DM * 2 * DFF; ld = 2 * DFF; col = r0; K = DM; WT = (bf16_t*)(dob + DO_WUP) + (size_t)r0 * DM; } \
            else { const int i2 = it - 30976; kb = i2 % 88; const int r0 = 32 * (i2 / 88); W = P.w_down + (size_t)l * DFF * DM; ld = DM; col = r0; K = DFF; WT = (bf16_t*)(dob + DO_WD) + (size_t)r0 * DFF; } \
        const int k0 = 64 * kb;
#define CONV_LOAD(dst) do { _Pragma("unroll") for (int i = 0; i < 32; ++i) { const int kk = 2 * i + (lane >> 5); dst[i] = W[(size_t)(k0 + kk) * ld + col + (lane & 31)]; } } while (0)
    float wn_[32];
    if (gw < 36608) { const int it = gw; CONV_DECODE(it) CONV_LOAD(wn_); }
    for (int it = gw; it < 36608; it += NGW) {
        bf16_t* WTc; int Kc, k0c;
        { CONV_DECODE(it) WTc = WT; Kc = K; k0c = k0; (void)W; (void)ld; (void)col; }
        float wv_[32];
#pragma unroll
        for (int i = 0; i < 32; ++i) wv_[i] = wn_[i];
        if (it + NGW < 36608) { const int it2 = it + NGW; CONV_DECODE(it2) CONV_LOAD(wn_); }
#pragma unroll
        for (int i = 0; i < 32; ++i) { const int kk = 2 * i + (lane >> 5); scr[kk * 33 + (lane & 31)] = wv_[i]; }
        asm volatile("s_waitcnt lgkmcnt(0)" ::: "memory");
        const int cc = lane & 7;
#pragma unroll
        for (int j = 0; j < 4; ++j) { const int n = (lane >> 3) + 8 * j; const float* s = scr + (8 * cc) * 33 + n;
            u32x4 o; o.x = pk2(s[0 * 33], s[1 * 33]); o.y = pk2(s[2 * 33], s[3 * 33]); o.z = pk2(s[4 * 33], s[5 * 33]); o.w = pk2(s[6 * 33], s[7 * 33]);
            *(u32x4*)(WTc + (size_t)n * Kc + k0c + 8 * cc) = o; }
        asm volatile("s_waitcnt lgkmcnt(0)" ::: "memory");
    }
#undef CONV_DECODE
#undef CONV_LOAD
    bf16_t* WdtT = (bf16_t*)(dob + DO_WDT);
    for (int idx = gw * 64 + lane; idx < 16 * DM; idx += NGW * 64) { const int j = idx >> 11, k = idx & 2047; WdtT[idx] = (bf16_t)f2bf(win[(size_t)k * DIN + 4352 + j]); }
}

template <int MODE> __device__ __forceinline__ void norm_phase(const Ptrs& P, const float* nw, int gw, int NGW, int lane) {
    bf16_t* H = (bf16_t*)(P.ws + WS_H); bf16_t* U = (bf16_t*)(P.ws + WS_U);
    const int nrows = (MODE == 2) ? MMAIN : MTOK;
    f32x4 xn[8]; u32x2 hn[8];
#define NORM_LOAD(r_) do { const int rr_ = (r_); if (MODE == 1) { const float* src = (rr_ < MMAIN) ? (P.x + (size_t)rr_ * DM) : (P.meta + (size_t)((rr_ - MMAIN) & 15) * DM); \
        _Pragma("unroll") for (int j = 0; j < 8; ++j) xn[j] = ((const f32x4*)src)[64 * j + lane]; } \
      else { _Pragma("unroll") for (int j = 0; j < 8; ++j) hn[j] = ((const u32x2*)(H + (size_t)rr_ * DM))[64 * j + lane]; } } while (0)
    int row = gw;
    if (row < nrows) NORM_LOAD(row);
    for (; row < nrows; row += NGW) {
        f32x4 v[8]; float ss = 0.f;
#pragma unroll
        for (int j = 0; j < 8; ++j) v[j] = (MODE == 1) ? xn[j] : (f32x4){bflo(hn[j].x), bfhi(hn[j].x), bflo(hn[j].y), bfhi(hn[j].y)};
        if (row + NGW < nrows) NORM_LOAD(row + NGW);
#pragma unroll
        for (int j = 0; j < 8; ++j) ss += (v[j][0] * v[j][0] + v[j][1] * v[j][1]) + (v[j][2] * v[j][2] + v[j][3] * v[j][3]);
        ss = wave_sum(ss, lane);
        const float rstd = 1.0f / sqrtf(ss * (1.0f / DM) + EPS);
        if (MODE == 1) {
#pragma unroll
            for (int j = 0; j < 8; ++j) { u32x2 w; w.x = pk2(v[j][0], v[j][1]); w.y = pk2(v[j][2], v[j][3]); ((u32x2*)(H + (size_t)row * DM))[64 * j + lane] = w; }
        }
#pragma unroll
        for (int j = 0; j < 8; ++j) {
            const f32x4 w4 = ((const f32x4*)nw)[64 * j + lane];
            const f32x4 o = v[j] * rstd * w4;
            if (MODE == 2) ((f32x4*)(P.out + (size_t)row * DM))[64 * j + lane] = o;
            else { u32x2 w; w.x = pk2(o[0], o[1]); w.y = pk2(o[2], o[3]); ((u32x2*)(U + (size_t)row * DM))[64 * j + lane] = w; }
        }
    }
#undef NORM_LOAD
}

__device__ __forceinline__ void dt_phase(const Ptrs& P, int gw, int NGW, int lane) {
    const bf16_t* U = (const bf16_t*)(P.ws + WS_U); const bf16_t* WdtT = (const bf16_t*)((unsigned char*)P.out + DO_WDT); float* dtraw = (float*)((unsigned char*)P.out + DO_DTRAW);
    const int lc = lane & 15, g = lane >> 4;
    for (int it = gw; it < MTOK / 16; it += NGW) {
        const int r0 = 16 * it; f32x4 acc = {0.f, 0.f, 0.f, 0.f};
        const bf16_t* ap = U + (size_t)(r0 + lc) * DM + 8 * g; const bf16_t* bp = WdtT + (size_t)lc * DM + 8 * g;
#pragma unroll 8
        for (int ks = 0; ks < 64; ++ks) { const bf16x8 a = *(const bf16x8*)(ap + ks * 32); const bf16x8 b = *(const bf16x8*)(bp + ks * 32); acc = mfma32(a, b, acc); }
#pragma unroll
        for (int r = 0; r < 4; ++r) dtraw[(size_t)(r0 + 4 * g + r) * 16 + lc] = acc[r];
    }
}

constexpr int AT_KS = 0, AT_VT = 36864, AT_KM = 72704, AT_HB = 75008, AT_BKT = 159744, AT_RB = 160256;
__device__ __forceinline__ void attn_tables(const Ptrs& P, unsigned char* lds, int tid) {
    int* bkt = (int*)(lds + AT_BKT); float* rb = (float*)(lds + AT_RB);
    if (tid < 128) { int bk; if (tid < 16) bk = tid; else { const float nf = (float)tid; int lg = 16 + (int)(logf(nf / 16.0f) / 2.0794415416798357f * 16.0f); bk = lg < 31 ? lg : 31; } bkt[tid] = bk; }
    rb[tid] = P.rel_bias[tid];
}
__device__ __forceinline__ void attn_unit(const Ptrs& P, int l, int b, int gk, int n, unsigned char* lds, int tid, bool dost) {
    bf16_t* PJ = (bf16_t*)(P.ws + WS_R);
    const int lane = tid & 63, w = tid >> 6, lc = lane & 15, g = lane >> 4;
    bf16_t* Vt = (bf16_t*)(lds + AT_VT); const int* bkt = (const int*)(lds + AT_BKT); const float* rb = (const float*)(lds + AT_RB); float* hb = (float*)(lds + AT_HB);
    {
        const int key = tid >> 1, half = tid & 1; const bool valid = (n >= 2) || (n == 1 && key >= 128);
        u32x4 kv[4], vv[4];
        if (valid) { const bf16_t* rp = PJ + (size_t)(b * SEQ + (n - 2) * 128 + key) * PW + gk * 64 + half * 32;
#pragma unroll
            for (int i = 0; i < 4; ++i) { kv[i] = *(const u32x4*)(rp + C_AK + 8 * i); vv[i] = *(const u32x4*)(rp + C_AV + 8 * i); } }
        else {
#pragma unroll
            for (int i = 0; i < 4; ++i) { kv[i] = (u32x4){0u, 0u, 0u, 0u}; vv[i] = (u32x4){0u, 0u, 0u, 0u}; } }
#pragma unroll
        for (int i = 0; i < 4; ++i) {
            *(u32x4*)(lds + AT_KS + key * 144 + half * 64 + i * 16) = kv[i];
            const int d0 = half * 32 + i * 8;
            Vt[(d0 + 0) * 280 + key] = (bf16_t)(vv[i].x & 0xffffu); Vt[(d0 + 1) * 280 + key] = (bf16_t)(vv[i].x >> 16);
            Vt[(d0 + 2) * 280 + key] = (bf16_t)(vv[i].y & 0xffffu); Vt[(d0 + 3) * 280 + key] = (bf16_t)(vv[i].y >> 16);
            Vt[(d0 + 4) * 280 + key] = (bf16_t)(vv[i].z & 0xffffu); Vt[(d0 + 5) * 280 + key] = (bf16_t)(vv[i].z >> 16);
            Vt[(d0 + 6) * 280 + key] = (bf16_t)(vv[i].w & 0xffffu); Vt[(d0 + 7) * 280 + key] = (bf16_t)(vv[i].w >> 16);
        }
    }
    if (tid < 32) {
        const int m = tid >> 1, half = tid & 1; const bf16_t* rp = PJ + (size_t)(MMAIN + b * NMETA + m) * PW + gk * 64 + half * 32;
#pragma unroll
        for (int i = 0; i < 4; ++i) { const u32x4 kvv = *(const u32x4*)(rp + C_AK + 8 * i); const u32x4 vvv = *(const u32x4*)(rp + C_AV + 8 * i);
            *(u32x4*)(lds + AT_KM + m * 144 + half * 64 + i * 16) = kvv;
            const int d0 = half * 32 + i * 8;
            Vt[(d0 + 0) * 280 + 256 + m] = (bf16_t)(vvv.x & 0xffffu); Vt[(d0 + 1) * 280 + 256 + m] = (bf16_t)(vvv.x >> 16);
            Vt[(d0 + 2) * 280 + 256 + m] = (bf16_t)(vvv.y & 0xffffu); Vt[(d0 + 3) * 280 + 256 + m] = (bf16_t)(vvv.y >> 16);
            Vt[(d0 + 4) * 280 + 256 + m] = (bf16_t)(vvv.z & 0xffffu); Vt[(d0 + 5) * 280 + 256 + m] = (bf16_t)(vvv.z >> 16);
            Vt[(d0 + 6) * 280 + 256 + m] = (bf16_t)(vvv.w & 0xffffu); Vt[(d0 + 7) * 280 + 256 + m] = (bf16_t)(vvv.w >> 16); }
    }
    const int head = gk * 8 + w;
    hb[w * 128 + lane] = rb[bkt[lane] * 16 + head]; hb[w * 128 + 64 + lane] = rb[bkt[64 + lane] * 16 + head];
    __syncthreads();
    const float sink = P.att_sinks[l * 16 + head];
    const int qs0 = (n == 0) ? 7 : 0;
    bf16x8 qn0, qn1;
    { const bf16_t* qp = PJ + (size_t)tok_row(b, n * 128 + 16 * qs0 + lc - 112) * PW + C_AQ + head * 64; qn0 = *(const bf16x8*)(qp + 8 * g); qn1 = *(const bf16x8*)(qp + 32 + 8 * g); }
#pragma unroll 1
    for (int qs = qs0; qs < 8; ++qs) {
        const int tq = n * 128 + 16 * qs + lc - 112;
        const size_t qrow = (size_t)tok_row(b, tq);
        bf16_t* qp = PJ + qrow * PW + C_AQ + head * 64;
        const bf16x8 q0 = qn0, q1 = qn1;
        if (qs + 1 < 8) { const bf16_t* qp2 = PJ + (size_t)tok_row(b, tq + 16) * PW + C_AQ + head * 64; qn0 = *(const bf16x8*)(qp2 + 8 * g); qn1 = *(const bf16x8*)(qp2 + 32 + 8 * g); }
        f32x4 st[10];
#pragma unroll
        for (int kt = 0; kt < 9; ++kt) { const unsigned char* kp = lds + AT_KS + (16 * (qs + kt) + lc) * 144 + 16 * g;
            const bf16x8 a0 = *(const bf16x8*)kp, a1 = *(const bf16x8*)(kp + 64);
            f32x4 z = {0.f, 0.f, 0.f, 0.f}; z = mfma32(a0, q0, z); st[kt] = mfma32(a1, q1, z); }
        { const unsigned char* kp = lds + AT_KM + lc * 144 + 16 * g; const bf16x8 a0 = *(const bf16x8*)kp, a1 = *(const bf16x8*)(kp + 64);
            f32x4 z = {0.f, 0.f, 0.f, 0.f}; z = mfma32(a0, q0, z); st[9] = mfma32(a1, q1, z); }
        float mx = sink;
#pragma unroll
        for (int kt = 0; kt < 9; ++kt)
#pragma unroll
            for (int r = 0; r < 4; ++r) { const int dist = 128 + lc - 16 * kt - 4 * g - r; const int j = 16 * (qs + kt) + 4 * g + r;
                const bool valid = (dist >= 0) && (dist < 128) && (n >= 1) && (n >= 2 || j >= 128);
                const float lg = valid ? (st[kt][r] * 0.125f + hb[w * 128 + (dist & 127)]) : NEGV; st[kt][r] = lg; mx = fmaxf(mx, lg); }
#pragma unroll
        for (int r = 0; r < 4; ++r) { const int dist = tq - (4 * g + r); const bool valid = dist >= 0; const int bk = (dist >= 0 && dist < 128) ? bkt[dist & 127] : 31;
            const float lg = valid ? (st[9][r] * 0.125f + rb[bk * 16 + head]) : NEGV; st[9][r] = lg; mx = fmaxf(mx, lg); }
        mx = fmaxf(mx, shx(mx, 16, lane)); mx = fmaxf(mx, shx(mx, 32, lane));
        float sum = 0.f;
#pragma unroll
        for (int kt = 0; kt < 10; ++kt)
#pragma unroll
            for (int r = 0; r < 4; ++r) { const float p = __expf(st[kt][r] - mx); st[kt][r] = p; sum += p; }
        sum += shx(sum, 16, lane); sum += shx(sum, 32, lane);
        const float inv = 1.0f / (sum + __expf(sink - mx));
        f32x4 o[4];
#pragma unroll
        for (int dt = 0; dt < 4; ++dt) o[dt] = (f32x4){0.f, 0.f, 0.f, 0.f};
#pragma unroll
        for (int j = 0; j < 5; ++j) {
            const bf16x8 pb = pack8(st[2 * j], st[2 * j + 1]);
            const int colA = 16 * (qs + 2 * j) + 4 * g; const int colB = (j < 4) ? (16 * (qs + 2 * j + 1) + 4 * g) : (256 + 4 * g);
#pragma unroll
            for (int dt = 0; dt < 4; ++dt) { const int d = 16 * dt + lc;
                const u32x2 lo = *(const u32x2*)(Vt + d * 280 + colA), hi = *(const u32x2*)(Vt + d * 280 + colB);
                o[dt] = mfma32(cat8(lo, hi), pb, o[dt]); }
        }
#pragma unroll
        for (int dt = 0; dt < 4; ++dt) { u32x2 wv; wv.x = pk2(o[dt][0] * inv, o[dt][1] * inv); wv.y = pk2(o[dt][2] * inv, o[dt][3] * inv); if (dost) *(u32x2*)(qp + 16 * dt + 4 * g) = wv; }
    }
    __syncthreads();
}

constexpr int SD_XT = 0, SD_BS = 69632, SD_CS = 104448, SD_ACS = 139264, SD_DTS = 141312, SD_SSQ = 143360, SD_WS = 145408;
__device__ __forceinline__ int sdz(int row, int col) { return row * 136 + (col ^ (((row >> 3) & 15) << 3)); }
template <bool PASSA> __device__ __forceinline__ void ssd_stage(const Ptrs& P, int l, int b, int ch, int gg, unsigned char* lds, int tid) {
    const bf16_t* PJ = (const bf16_t*)(P.ws + WS_R);
    const int lane = tid & 63, seg = tid >> 6, l0 = 16 * seg, nvalid = (ch == 0) ? 16 : 128;
    bf16_t* Xt = (bf16_t*)(lds + SD_XT); bf16_t* Bs = (bf16_t*)(lds + SD_BS); bf16_t* Cs = (bf16_t*)(lds + SD_CS);
    int kind, xcol, i0;
    if (lane < 32) { kind = 0; i0 = 8 * lane; xcol = gg * 256 + i0; }
    else if (lane < 48) { kind = 1; i0 = 8 * (lane - 32); xcol = 1024 + gg * 128 + i0; }
    else { kind = 2; i0 = 8 * (lane - 48); xcol = 1536 + gg * 128 + i0; }
    if (!(PASSA && kind == 2)) {
        float wgt[4][8], bias[8];
        const float* cw = P.ssd_conv_w + (size_t)l * 4 * 2048 + xcol; const float* cb = P.ssd_conv_b + (size_t)l * 2048 + xcol;
#pragma unroll
        for (int k = 0; k < 4; ++k) { const f32x4 a = *(const f32x4*)(cw + k * 2048), c2 = *(const f32x4*)(cw + k * 2048 + 4);
            wgt[k][0] = a[0]; wgt[k][1] = a[1]; wgt[k][2] = a[2]; wgt[k][3] = a[3]; wgt[k][4] = c2[0]; wgt[k][5] = c2[1]; wgt[k][6] = c2[2]; wgt[k][7] = c2[3]; }
        { const f32x4 a = *(const f32x4*)cb, c2 = *(const f32x4*)(cb + 4); bias[0] = a[0]; bias[1] = a[1]; bias[2] = a[2]; bias[3] = a[3]; bias[4] = c2[0]; bias[5] = c2[1]; bias[6] = c2[2]; bias[7] = c2[3]; }
        const int t0 = (ch == 0) ? l0 : (NMETA + 128 * (ch - 1) + l0);
        float x0[8], x1[8], x2[8], x3[8];
        const bool live = l0 < nvalid;
#define SSD_LDX(dst, tt) do { const int t_ = (tt); if (live && t_ >= 0) { const u32x4 w_ = *(const u32x4*)(PJ + (size_t)tok_row(b, t_) * PW + C_XBC + xcol); unpack8(w_, dst); } \
            else { _Pragma("unroll") for (int e_ = 0; e_ < 8; ++e_) dst[e_] = 0.f; } } while (0)
#define SSD_LD(tt) ((live && (tt) >= 0) ? *(const u32x4*)(PJ + (size_t)tok_row(b, (tt)) * PW + C_XBC + xcol) : (u32x4){0u, 0u, 0u, 0u})
        { const u32x4 h0 = SSD_LD(t0 - 3), h1 = SSD_LD(t0 - 2), h2 = SSD_LD(t0 - 1); unpack8(h0, x0); unpack8(h1, x1); unpack8(h2, x2); }
        u32x4 n0 = SSD_LD(t0), n1 = SSD_LD(t0 + 1), n2 = SSD_LD(t0 + 2), n3 = SSD_LD(t0 + 3);
#pragma unroll 1
        for (int i = 0; i < 16; ++i) {
            const int li = l0 + i;
            unpack8(n0, x3); n0 = n1; n1 = n2; n2 = n3; n3 = (i + 4 < 16) ? SSD_LD(t0 + i + 4) : (u32x4){0u, 0u, 0u, 0u};
            float o[8];
#pragma unroll
            for (int e = 0; e < 8; ++e) { float v = bias[e] + wgt[0][e] * x0[e] + wgt[1][e] * x1[e] + wgt[2][e] * x2[e] + wgt[3][e] * x3[e]; v = siluf(v); o[e] = (li < nvalid) ? v : 0.f;
                x0[e] = x1[e]; x1[e] = x2[e]; x2[e] = x3[e]; }
            if (kind == 0) {
#pragma unroll
                for (int e = 0; e < 8; ++e) Xt[sdz(i0 + e, li)] = (bf16_t)f2bf(o[e]);
            } else if (kind == 1) {
                if (PASSA) {
#pragma unroll
                    for (int e = 0; e < 8; ++e) Bs[sdz(i0 + e, li)] = (bf16_t)f2bf(o[e]);
                } else { u32x4 wv; wv.x = pk2(o[0], o[1]); wv.y = pk2(o[2], o[3]); wv.z = pk2(o[4], o[5]); wv.w = pk2(o[6], o[7]); *(u32x4*)(Bs + li * 136 + i0) = wv; }
            } else { u32x4 wv; wv.x = pk2(o[0], o[1]); wv.y = pk2(o[2], o[3]); wv.z = pk2(o[4], o[5]); wv.w = pk2(o[6], o[7]); *(u32x4*)(Cs + li * 136 + i0) = wv; }
        }
#undef SSD_LD
#undef SSD_LDX
    }
    float* ACS = (float*)(lds + SD_ACS); float* DTS = (float*)(lds + SD_DTS);
    { const int hh = tid >> 7, li = tid & 127; const int h = gg * 4 + hh; float dt = 0.f, dA = 0.f;
      if (li < nvalid) { const int row = (ch == 0) ? (MMAIN + b * NMETA + li) : (b * SEQ + 128 * (ch - 1) + li);
          const float* dtraw = (const float*)((const unsigned char*)P.out + DO_DTRAW);
          const float raw = dtraw[(size_t)row * 16 + h] + P.ssd_dt_bias[l * 16 + h];
          dt = raw > 20.f ? raw : log1pf(__expf(raw)); dA = -dt * __expf(P.ssd_a_log[l * 16 + h]); }
      DTS[hh * 128 + li] = dt; ACS[hh * 128 + li] = dA; }
    __syncthreads();
    if (seg < 4) { const int hh = seg; const float v0 = ACS[hh * 128 + 2 * lane], v1 = ACS[hh * 128 + 2 * lane + 1]; const float s = v0 + v1; float sc = s;
#pragma unroll
        for (int o = 1; o < 64; o <<= 1) { const float t = __builtin_bit_cast(float, __builtin_amdgcn_ds_bpermute(((lane - o) & 63) << 2, __builtin_bit_cast(int, sc))); if (lane >= o) sc += t; }
        const float ex = sc - s; ACS[hh * 128 + 2 * lane] = ex + v0; ACS[hh * 128 + 2 * lane + 1] = ex + v0 + v1; }
    __syncthreads();
}

__device__ __forceinline__ void ssd_passA(const Ptrs& P, int l, int b, int ch, int gg, unsigned char* lds, int tid) {
    ssd_stage<true>(P, l, b, ch, gg, lds, tid);
    const int lane = tid & 63, w = tid >> 6, lc = lane & 15, g = lane >> 4, hh = w & 3, half = w >> 2, h = gg * 4 + hh;
    const float* ACS = (const float*)(lds + SD_ACS); const float* DTS = (const float*)(lds + SD_DTS); float* WSg = (float*)(lds + SD_WS);
    const bf16_t* Xt = (const bf16_t*)(lds + SD_XT); const bf16_t* Bt = (const bf16_t*)(lds + SD_BS);
    { const int h2 = tid >> 7, s = tid & 127; WSg[h2 * 128 + s] = __expf(ACS[h2 * 128 + 127] - ACS[h2 * 128 + s]) * DTS[h2 * 128 + s]; }
    __syncthreads();
    bf16x8 af[4][4];
#pragma unroll
    for (int pt = 0; pt < 4; ++pt)
#pragma unroll
        for (int ks = 0; ks < 4; ++ks) { const u32x4 raw = *(const u32x4*)(Xt + sdz(hh * 64 + 16 * pt + lc, 32 * ks + 8 * g)); float f[8]; unpack8(raw, f);
            const float* wp = WSg + hh * 128 + 32 * ks + 8 * g;
            u32x4 o; o.x = pk2(f[0] * wp[0], f[1] * wp[1]); o.y = pk2(f[2] * wp[2], f[3] * wp[3]); o.z = pk2(f[4] * wp[4], f[5] * wp[5]); o.w = pk2(f[6] * wp[6], f[7] * wp[7]);
            af[pt][ks] = __builtin_bit_cast(bf16x8, o); }
    bf16_t* ST = (bf16_t*)(P.ws + WS_X) + (size_t)((b * NCH + ch) * 16 + h) * 8192;
#pragma unroll 1
    for (int nt = 4 * half; nt < 4 * half + 4; ++nt) {
        f32x4 st[4];
#pragma unroll
        for (int pt = 0; pt < 4; ++pt) st[pt] = (f32x4){0.f, 0.f, 0.f, 0.f};
#pragma unroll
        for (int ks = 0; ks < 4; ++ks) { const bf16x8 bfr = *(const bf16x8*)(Bt + sdz(16 * nt + lc, 32 * ks + 8 * g));
#pragma unroll
            for (int pt = 0; pt < 4; ++pt) st[pt] = mfma32(af[pt][ks], bfr, st[pt]); }
#pragma unroll
        for (int pt = 0; pt < 4; ++pt)
#pragma unroll
            for (int r = 0; r < 4; ++r) ST[(16 * pt + 4 * g + r) * 128 + 16 * nt + lc] = (bf16_t)f2bf(st[pt][r]);
    }
    if (tid < 4) { float* dec = (float*)((unsigned char*)P.out + DO_SSDDEC); dec[(b * NCH + ch) * 16 + gg * 4 + tid] = __expf(ACS[tid * 128 + 127]); }
    __syncthreads();
}

__device__ __forceinline__ void ssd_passB(const Ptrs& P, int l, int b, int ch, int gg, unsigned char* lds, int tid, bool dost) {
    ssd_stage<false>(P, l, b, ch, gg, lds, tid);
    bf16_t* PJ = (bf16_t*)(P.ws + WS_R);
    const int lane = tid & 63, w = tid >> 6, lc = lane & 15, g = lane >> 4, hh = w & 3, half = w >> 2, h = gg * 4 + hh;
    const float* ACS = (const float*)(lds + SD_ACS) + hh * 128; const float* DTS = (const float*)(lds + SD_DTS) + hh * 128; float* SSQ = (float*)(lds + SD_SSQ);
    const bf16_t* Xt = (const bf16_t*)(lds + SD_XT); const bf16_t* Bs = (const bf16_t*)(lds + SD_BS); const bf16_t* Cs = (const bf16_t*)(lds + SD_CS);
    const bf16_t* ST = (const bf16_t*)(P.ws + WS_X) + (size_t)((b * NCH + ch) * 16 + h) * 8192;
    const int nlt = (ch == 0) ? (half == 0 ? 1 : 0) : 4;
    const float dsk = P.ssd_d[l * 16 + h];
    bf16x8 sf[4][4];
#pragma unroll
    for (int pt = 0; pt < 4; ++pt)
#pragma unroll
        for (int ks = 0; ks < 4; ++ks) sf[pt][ks] = *(const bf16x8*)(ST + (16 * pt + lc) * 128 + 32 * ks + 8 * g);
    u32x2 zwv[4][4];
#pragma unroll
    for (int lti = 0; lti < 4; ++lti) {
        const int lt = (lti == 0) ? half : (lti == 1) ? 3 - half : (lti == 2) ? 4 + half : 7 - half, li = 16 * lt + lc;
        const bool rv = (lti < nlt) && ((ch != 0) || (li < 16));
        const size_t row = (ch == 0) ? (size_t)(MMAIN + b * NMETA + (li & 15)) : (size_t)(b * SEQ + 128 * (ch - 1) + li);
#pragma unroll
        for (int pt = 0; pt < 4; ++pt) { zwv[lti][pt] = (u32x2){0u, 0u}; if (rv) zwv[lti][pt] = *(const u32x2*)(PJ + row * PW + C_SZ + h * 64 + 16 * pt + 4 * g); } }
    f32x4 gz[4][4];
#pragma unroll
    for (int lti = 0; lti < 4; ++lti) {
#pragma unroll
        for (int pt = 0; pt < 4; ++pt) gz[lti][pt] = (f32x4){0.f, 0.f, 0.f, 0.f};
        if (lti < nlt) {
            const int lt = (lti == 0) ? half : (lti == 1) ? 3 - half : (lti == 2) ? 4 + half : 7 - half, li = 16 * lt + lc; const float Al = ACS[li];
            bf16x8 cf[4];
#pragma unroll
            for (int ks = 0; ks < 4; ++ks) cf[ks] = *(const bf16x8*)(Cs + li * 136 + 32 * ks + 8 * g);
            f32x4 o[4];
#pragma unroll
            for (int pt = 0; pt < 4; ++pt) { f32x4 z = {0.f, 0.f, 0.f, 0.f};
#pragma unroll
                for (int ks = 0; ks < 4; ++ks) z = mfma32(sf[pt][ks], cf[ks], z);
                const float eA = __expf(Al); o[pt] = z * eA; }
            for (int j = 0; j <= (lt >> 1); ++j) {
                f32x4 cb0 = {0.f, 0.f, 0.f, 0.f}, cb1 = {0.f, 0.f, 0.f, 0.f};
#pragma unroll
                for (int ks = 0; ks < 4; ++ks) { const bf16x8 a0 = *(const bf16x8*)(Bs + (32 * j + lc) * 136 + 32 * ks + 8 * g), a1 = *(const bf16x8*)(Bs + (32 * j + 16 + lc) * 136 + 32 * ks + 8 * g);
                    cb0 = mfma32(a0, cf[ks], cb0); cb1 = mfma32(a1, cf[ks], cb1); }
#pragma unroll
                for (int r = 0; r < 4; ++r) { const int s0 = 32 * j + 4 * g + r, s1 = s0 + 16;
                    cb0[r] = (s0 <= li) ? cb0[r] * __expf(Al - ACS[s0]) * DTS[s0] : 0.f;
                    cb1[r] = (s1 <= li) ? cb1[r] * __expf(Al - ACS[s1]) * DTS[s1] : 0.f; }
                const bf16x8 pb = pack8(cb0, cb1);
#pragma unroll
                for (int pt = 0; pt < 4; ++pt) { const int xr = hh * 64 + 16 * pt + lc;
                    const u32x2 lo = *(const u32x2*)(Xt + sdz(xr, 32 * j + 4 * g)), hi = *(const u32x2*)(Xt + sdz(xr, 32 * j + 16 + 4 * g)); o[pt] = mfma32(cat8(lo, hi), pb, o[pt]); }
            }
            const bool rv = (ch != 0) || (li < 16);
            const size_t row = (ch == 0) ? (size_t)(MMAIN + b * NMETA + (li & 15)) : (size_t)(b * SEQ + 128 * (ch - 1) + li);
            float part = 0.f;
#pragma unroll
            for (int pt = 0; pt < 4; ++pt) { const u32x2 zw = zwv[lti][pt];
                const float zf[4] = {bflo(zw.x), bfhi(zw.x), bflo(zw.y), bfhi(zw.y)};
#pragma unroll
                for (int r = 0; r < 4; ++r) { const float xs = bf2f(Xt[sdz(hh * 64 + 16 * pt + 4 * g + r, li)]); const float y = o[pt][r] + xs * dsk; const float v = y * siluf(zf[r]); gz[lti][pt][r] = v; part += v * v; } }
            part += shx(part, 16, lane); part += shx(part, 32, lane);
            if (g == 0) SSQ[li * 4 + hh] = part;
        }
    }
    f32x4 nwv[4];
#pragma unroll
    for (int pt = 0; pt < 4; ++pt) nwv[pt] = *(const f32x4*)(P.ssd_norm_w + l * 1024 + h * 64 + 16 * pt + 4 * g);
    __syncthreads();
#pragma unroll
    for (int lti = 0; lti < 4; ++lti) {
        if (lti < nlt) {
            const int lt = (lti == 0) ? half : (lti == 1) ? 3 - half : (lti == 2) ? 4 + half : 7 - half, li = 16 * lt + lc;
            const bool rv = (ch != 0) || (li < 16);
            const size_t row = (ch == 0) ? (size_t)(MMAIN + b * NMETA + (li & 15)) : (size_t)(b * SEQ + 128 * (ch - 1) + li);
            const float tot = (SSQ[li * 4 + 0] + SSQ[li * 4 + 1]) + (SSQ[li * 4 + 2] + SSQ[li * 4 + 3]);
            const float rstd = 1.0f / sqrtf(tot * (1.0f / 256.0f) + EPS);
            if (rv && dost) {
#pragma unroll
                for (int pt = 0; pt < 4; ++pt) { const f32x4 nw = nwv[pt];
                    u32x2 wv; wv.x = pk2(gz[lti][pt][0] * rstd * nw[0], gz[lti][pt][1] * rstd * nw[1]); wv.y = pk2(gz[lti][pt][2] * rstd * nw[2], gz[lti][pt][3] * rstd * nw[3]);
                    *(u32x2*)(PJ + row * PW + C_SZ + h * 64 + 16 * pt + 4 * g) = wv; }
            }
        }
    }
    __syncthreads();
}

constexpr int HG_QB = 0, HG_KB = 34816, HG_KET = 69632, HG_EBE = 110592, HG_VT = 114688, HG_SSQ = 155648;
__device__ __forceinline__ void hg_unit(const Ptrs& P, int l, int b, int hd, int ch, unsigned char* lds, int tid) {
    bf16_t* PJ = (bf16_t*)(P.ws + WS_R);
    const int lane = tid & 63, w = tid >> 6, lc = lane & 15, g = lane >> 4;
    const int nsub = (ch == 0) ? 1 : 8;
    const size_t row0 = (ch == 0) ? (size_t)(MMAIN + b * NMETA) : (size_t)(b * SEQ + 128 * (ch - 1));
    bf16_t* Qb = (bf16_t*)(lds + HG_QB); bf16_t* Kb = (bf16_t*)(lds + HG_KB); bf16_t* Ket = (bf16_t*)(lds + HG_KET); float* EBE = (float*)(lds + HG_EBE);
    bf16_t* Vt = (bf16_t*)(lds + HG_VT) + w * 8 * 16 * 20; float* DT = (float*)(lds + HG_SSQ);
    bf16_t* HS = (bf16_t*)((unsigned char*)P.out + DO_HGS) + (size_t)((b * 8 + hd) * NCH + ch) * 16384;
    u32x2 vv[8];
    { const int t = lane >> 2, v4 = (lane & 3) * 4;
#pragma unroll
      for (int j = 0; j < 8; ++j) { vv[j] = (u32x2){0u, 0u}; if (j < nsub) vv[j] = *(const u32x2*)(PJ + (row0 + 16 * j + t) * PW + C_HI + hd * 128 + 16 * w + v4); } }
    {
        const int dk = tid & 127, sg = tid >> 7;
        float lb = 0.f;
        if (l == 1) { const float a0 = P.lb_logits[hd * 128 + dk], a1 = P.lb_logits[1024 + hd * 128 + dk]; const float mxx = fmaxf(a0, a1); const float e0 = __expf(a0 - mxx), e1 = __expf(a1 - mxx);
            lb = e1 / (e0 + e1); lb = fminf(fmaxf(lb, 0.f), 1.0f - 1e-4f); }
        bf16_t hfv[2][16], hqv[2][16];
#pragma unroll
        for (int jj = 0; jj < 2; ++jj) { const int j = 2 * sg + jj;
#pragma unroll
            for (int t = 0; t < 16; ++t) { hfv[jj][t] = 0; hqv[jj][t] = 0;
                if (j < nsub) { const bf16_t* rp = PJ + (row0 + 16 * j + t) * PW + hd * 128 + dk; hfv[jj][t] = rp[C_HF]; hqv[jj][t] = rp[C_HQ]; } } }
#pragma unroll
        for (int jj = 0; jj < 2; ++jj) { const int j = 2 * sg + jj;
            if (j < nsub) {
                float kk[16]; float eb = 1.f;
#pragma unroll
                for (int t = 0; t < 16; ++t) {
                    const float ff = bf2f(hfv[jj][t]); const float qv = bf2f(hqv[jj][t]);
                    const float sg1 = sigm(ff); const float f = lb + (1.0f - lb) * sg1; eb *= f;
                    const float kv = (1.0f - lb) * (1.0f - sg1);
                    const float ebi = __builtin_amdgcn_rcpf(eb);
                    kk[t] = kv * ebi;
                    Qb[(16 * j + t) * 136 + dk] = (bf16_t)f2bf(siluf(qv) * eb);
                    Kb[(16 * j + t) * 136 + dk] = (bf16_t)f2bf(kk[t]); }
                const float ebe = eb;
#pragma unroll
                for (int t = 0; t < 16; t += 2) *(unsigned*)(Ket + (j * 128 + dk) * 20 + t) = pk2(kk[t] * ebe, kk[t + 1] * ebe);
                EBE[j * 128 + dk] = ebe;
            }
        }
    }
    { const int t = lane >> 2, v4 = (lane & 3) * 4;
#pragma unroll
      for (int j = 0; j < 8; ++j) { if (j < nsub) { bf16_t* vp = Vt + (j * 16 + v4) * 20 + t;
        vp[0] = (bf16_t)(vv[j].x & 0xffffu); vp[20] = (bf16_t)(vv[j].x >> 16); vp[40] = (bf16_t)(vv[j].y & 0xffffu); vp[60] = (bf16_t)(vv[j].y >> 16); } } }
    __syncthreads();
#define HG_ATT_SLOT(j_) (((lane >> 5) ? Kb : Qb) + (16 * (j_) + ((lane & 31) >> 1)) * 136 + 128 + 4 * (lane & 1))
    if (w < nsub) {
        f32x4 at = {0.f, 0.f, 0.f, 0.f};
#pragma unroll
        for (int ks = 0; ks < 4; ++ks) { const bf16x8 a = *(const bf16x8*)(Kb + (16 * w + lc) * 136 + 32 * ks + 8 * g), bq = *(const bf16x8*)(Qb + (16 * w + lc) * 136 + 32 * ks + 8 * g); at = mfma32(a, bq, at); }
#pragma unroll
        for (int r = 0; r < 4; ++r) at[r] = (4 * g + r <= lc) ? at[r] : 0.f;
        *(bf16x4*)HG_ATT_SLOT(w) = pack4(at);
    }
    if (tid < 128) { float d = 1.f;
        for (int j = 0; j < nsub; ++j) { DT[j * 128 + tid] = d; d *= EBE[j * 128 + tid]; }
        float* dec = (float*)((unsigned char*)P.out + DO_HGDEC); dec[(size_t)((b * 8 + hd) * NCH + ch) * 128 + tid] = d; }
    __syncthreads();
    {
        const int t = tid >> 2, sgm = tid & 3;
        if (t < 16 * nsub) { const int j = t >> 4; bf16_t* qo = PJ + (row0 + t) * PW + C_HQ + hd * 128 + 32 * sgm;
#pragma unroll
            for (int c8 = 0; c8 < 4; ++c8) { const u32x4 qw = *(const u32x4*)(Qb + t * 136 + 32 * sgm + 8 * c8); float f[8]; unpack8(qw, f);
                const f32x4 d0 = *(const f32x4*)(DT + j * 128 + 32 * sgm + 8 * c8), d1 = *(const f32x4*)(DT + j * 128 + 32 * sgm + 8 * c8 + 4);
                u32x4 o; o.x = pk2(f[0] * d0[0], f[1] * d0[1]); o.y = pk2(f[2] * d0[2], f[3] * d0[3]); o.z = pk2(f[4] * d1[0], f[5] * d1[1]); o.w = pk2(f[6] * d1[2], f[7] * d1[3]);
                *(u32x4*)(qo + 8 * c8) = o; } }
    }
    f32x4 S[8];
#pragma unroll
    for (int kt = 0; kt < 8; ++kt) S[kt] = (f32x4){0.f, 0.f, 0.f, 0.f};
#pragma unroll
    for (int j = 0; j < 8; ++j) {
        if (j < nsub) {
            const bf16x4 vf = *(const bf16x4*)(Vt + (j * 16 + lc) * 20 + 4 * g);
            const bf16x4 atj = *(const bf16x4*)HG_ATT_SLOT(j);
            f32x4 o = mfma16(vf, atj, (f32x4){0.f, 0.f, 0.f, 0.f});
            if (j > 0) {
#pragma unroll
                for (int kt = 0; kt < 8; ++kt) { const bf16x4 qf = *(const bf16x4*)(Qb + (16 * j + lc) * 136 + 16 * kt + 4 * g); o = mfma16(pack4(S[kt]), qf, o); } }
            { u32x2 wv; wv.x = pk2(o[0], o[1]); wv.y = pk2(o[2], o[3]); *(u32x2*)(PJ + (row0 + 16 * j + lc) * PW + C_HI + hd * 128 + 16 * w + 4 * g) = wv; }
#pragma unroll
            for (int kt = 0; kt < 8; ++kt) { const f32x4 eb = *(const f32x4*)(EBE + j * 128 + 16 * kt + 4 * g);
                const bf16x4 kf = *(const bf16x4*)(Ket + (j * 128 + 16 * kt + lc) * 20 + 4 * g);
                S[kt] = mfma16(kf, vf, S[kt] * eb); }
        }
    }
#pragma unroll
    for (int kt = 0; kt < 8; ++kt) { u32x2 wv; wv.x = pk2(S[kt][0], S[kt][1]); wv.y = pk2(S[kt][2], S[kt][3]); *(u32x2*)(HS + (16 * w + lc) * 128 + 16 * kt + 4 * g) = wv; }
    __syncthreads();
}

#undef HG_ATT_SLOT
__device__ __forceinline__ void hg_passB(const Ptrs& P, int l, int b, int hd, int ch, unsigned char* lds, int tid, bool dost) {
    bf16_t* PJ = (bf16_t*)(P.ws + WS_R);
    const int lane = tid & 63, w = tid >> 6, lc = lane & 15, g = lane >> 4;
    const int nsub = (ch == 0) ? 1 : 8;
    const size_t row0 = (ch == 0) ? (size_t)(MMAIN + b * NMETA) : (size_t)(b * SEQ + 128 * (ch - 1));
    float* SSQ = (float*)(lds + HG_SSQ);
    const bf16_t* HS = (const bf16_t*)((unsigned char*)P.out + DO_HGS) + (size_t)((b * 8 + hd) * NCH + ch) * 16384;
    bf16x8 sfr[4];
#pragma unroll
    for (int ks = 0; ks < 4; ++ks) sfr[ks] = *(const bf16x8*)(HS + (16 * w + lc) * 128 + 32 * ks + 8 * g);
    u32x2 ol[8], gv_[8];
#pragma unroll
    for (int j = 0; j < 8; ++j) { ol[j] = (u32x2){0u, 0u}; gv_[j] = ol[j];
        if (j < nsub) { const bf16_t* rp = PJ + (row0 + 16 * j + lc) * PW + hd * 128 + 16 * w + 4 * g; ol[j] = *(const u32x2*)(rp + C_HI); gv_[j] = *(const u32x2*)(rp + C_HG); } }
    bf16x8 qf[8][4];
#pragma unroll
    for (int j = 0; j < 8; ++j)
#pragma unroll
        for (int ks = 0; ks < 4; ++ks) { qf[j][ks] = (bf16x8){0, 0, 0, 0, 0, 0, 0, 0}; if (j < nsub) qf[j][ks] = *(const bf16x8*)(PJ + (row0 + 16 * j + lc) * PW + C_HQ + hd * 128 + 32 * ks + 8 * g); }
    f32x4 oo[8];
#pragma unroll
    for (int j = 0; j < 8; ++j) { f32x4 o = {bflo(ol[j].x), bfhi(ol[j].x), bflo(ol[j].y), bfhi(ol[j].y)};
#pragma unroll
        for (int ks = 0; ks < 4; ++ks) o = mfma32(sfr[ks], qf[j][ks], o);
        oo[j] = o; }
#pragma unroll
    for (int j = 0; j < 8; ++j) { float part = (oo[j][0] * oo[j][0] + oo[j][1] * oo[j][1]) + (oo[j][2] * oo[j][2] + oo[j][3] * oo[j][3]);
        part += shx(part, 16, lane); part += shx(part, 32, lane); if (g == 0) SSQ[w * 128 + 16 * j + lc] = part; }
    __syncthreads();
    const f32x4 nw = *(const f32x4*)(P.hg_norm_w + l * 128 + 16 * w + 4 * g);
#pragma unroll
    for (int j = 0; j < 8; ++j) {
        if (j < nsub) {
            float tot = 0.f;
#pragma unroll
            for (int ww = 0; ww < 8; ++ww) tot += SSQ[ww * 128 + 16 * j + lc];
            const float rstd = 1.0f / sqrtf(tot * (1.0f / 128.0f) + EPS);
            bf16_t* gp = PJ + (row0 + 16 * j + lc) * PW + C_HG + hd * 128 + 16 * w + 4 * g;
            const u32x2 gv = gv_[j];
            u32x2 wv; wv.x = pk2(oo[j][0] * rstd * nw[0] * siluf(bflo(gv.x)), oo[j][1] * rstd * nw[1] * siluf(bfhi(gv.x)));
            wv.y = pk2(oo[j][2] * rstd * nw[2] * siluf(bflo(gv.y)), oo[j][3] * rstd * nw[3] * siluf(bfhi(gv.y)));
            if (dost) *(u32x2*)gp = wv;
        }
    }
    __syncthreads();
}

__device__ __forceinline__ void scan_phase(const Ptrs& P, int tid) {
    constexpr int gsz = NGRID * 512;
    bf16_t* ST = (bf16_t*)(P.ws + WS_X); const float* decs = (const float*)((const unsigned char*)P.out + DO_SSDDEC);
    bf16_t* HS = (bf16_t*)((unsigned char*)P.out + DO_HGS); const float* dech = (const float*)((const unsigned char*)P.out + DO_HGDEC);
    for (int gid = blockIdx.x * 512 + tid; gid < 131072; gid += gsz) {
        const int bhs = gid >> 12, b = bhs >> 4, h = bhs & 15, idx = (gid & 4095) * 2;
        const int bh = gid >> 13, e = (gid & 8191) * 2, dk = e & 127;
        float r0 = 0.f, r1 = 0.f, q0 = 0.f, q1 = 0.f;
        for (int c0 = 0; c0 < NCH; c0 += 16) { unsigned v[16], w[16]; float d[16], f0[16], f1[16];
#pragma unroll
            for (int k = 0; k < 16; ++k) { const int ch = (c0 + k < NCH) ? c0 + k : NCH - 1;
                v[k] = *(const unsigned*)(ST + (size_t)((b * NCH + ch) * 16 + h) * 8192 + idx); d[k] = decs[(b * NCH + ch) * 16 + h];
                w[k] = *(const unsigned*)(HS + (size_t)(bh * NCH + ch) * 16384 + e); f0[k] = dech[(size_t)(bh * NCH + ch) * 128 + dk]; f1[k] = dech[(size_t)(bh * NCH + ch) * 128 + dk + 1]; }
#pragma unroll
            for (int k = 0; k < 16; ++k) { if (c0 + k < NCH) {
                *(unsigned*)(ST + (size_t)((b * NCH + c0 + k) * 16 + h) * 8192 + idx) = pk2(r0, r1); r0 = r0 * d[k] + bflo(v[k]); r1 = r1 * d[k] + bfhi(v[k]);
                *(unsigned*)(HS + (size_t)(bh * NCH + c0 + k) * 16384 + e) = pk2(q0, q1); q0 = q0 * f0[k] + bflo(w[k]); q1 = q1 * f1[k] + bfhi(w[k]); } } }
    }
}

__device__ __forceinline__ void ffn_act_phase(const Ptrs& P, int l, int half, int gw, int NGW, int lane) {
    const bf16_t* A2 = (const bf16_t*)(P.ws + WS_R); bf16_t* G2 = (bf16_t*)(P.ws + WS_R + (size_t)16640 * 11264 * 2);
    const float* cw = P.ffn_conv_w + (size_t)l * 3 * 2 * DFF; const float* cb = P.ffn_conv_b + (size_t)l * 2 * DFF;
    const int nblk = (half == 1) ? 513 : 512;
    for (int it = gw; it < nblk * 11; it += NGW) {
        const int rb = it / 11, cg = it - rb * 11, f0 = (cg * 64 + lane) * 8;
        float wg[3][8], wu[3][8], bg[8], bu[8];
#pragma unroll
        for (int k = 0; k < 3; ++k) { const f32x4 a = *(const f32x4*)(cw + k * 2 * DFF + f0), b2 = *(const f32x4*)(cw + k * 2 * DFF + f0 + 4), c = *(const f32x4*)(cw + k * 2 * DFF + DFF + f0), d = *(const f32x4*)(cw + k * 2 * DFF + DFF + f0 + 4);
#pragma unroll
            for (int e = 0; e < 4; ++e) { wg[k][e] = a[e]; wg[k][4 + e] = b2[e]; wu[k][e] = c[e]; wu[k][4 + e] = d[e]; } }
        { const f32x4 a = *(const f32x4*)(cb + f0), b2 = *(const f32x4*)(cb + f0 + 4), c = *(const f32x4*)(cb + DFF + f0), d = *(const f32x4*)(cb + DFF + f0 + 4);
#pragma unroll
          for (int e = 0; e < 4; ++e) { bg[e] = a[e]; bg[4 + e] = b2[e]; bu[e] = c[e]; bu[4 + e] = d[e]; } }
        const int lr0 = rb * 32; const bool meta = (rb == 512);
        u32x4 g2 = {0u, 0u, 0u, 0u}, g1 = g2, u2 = g2, u1 = g2;
        if (!meta) { const int r2 = (rb == 0) ? (SEQ + half * 16 + 14) : lr0 - 2, r1 = (rb == 0) ? (SEQ + half * 16 + 15) : lr0 - 1;
            g2 = *(const u32x4*)(A2 + (size_t)r2 * 11264 + f0); u2 = *(const u32x4*)(A2 + (size_t)r2 * 11264 + DFF + f0);
            g1 = *(const u32x4*)(A2 + (size_t)r1 * 11264 + f0); u1 = *(const u32x4*)(A2 + (size_t)r1 * 11264 + DFF + f0); }
        u32x4 gn[4], un[4];
#pragma unroll
        for (int i = 0; i < 4; ++i) { gn[i] = *(const u32x4*)(A2 + (size_t)(lr0 + i) * 11264 + f0); un[i] = *(const u32x4*)(A2 + (size_t)(lr0 + i) * 11264 + DFF + f0); }
#pragma unroll 1
        for (int i0 = 0; i0 < 32; i0 += 4) {
            u32x4 gc[4], uc[4];
#pragma unroll
            for (int i = 0; i < 4; ++i) { gc[i] = gn[i]; uc[i] = un[i]; }
            if (i0 + 4 < 32) {
#pragma unroll
                for (int i = 0; i < 4; ++i) { gn[i] = *(const u32x4*)(A2 + (size_t)(lr0 + i0 + 4 + i) * 11264 + f0); un[i] = *(const u32x4*)(A2 + (size_t)(lr0 + i0 + 4 + i) * 11264 + DFF + f0); } }
#pragma unroll
            for (int i = 0; i < 4; ++i) {
                if (meta && ((i0 + i) & 15) == 0) { g2 = (u32x4){0u, 0u, 0u, 0u}; g1 = g2; u2 = g2; u1 = g2; }
                float a2[8], a1[8], a0[8], c2[8], c1[8], c0[8], o[8];
                unpack8(g2, a2); unpack8(g1, a1); unpack8(gc[i], a0); unpack8(u2, c2); unpack8(u1, c1); unpack8(uc[i], c0);
#pragma unroll
                for (int e = 0; e < 8; ++e) { const float gv = bg[e] + wg[0][e] * a2[e] + wg[1][e] * a1[e] + wg[2][e] * a0[e]; const float uv = bu[e] + wu[0][e] * c2[e] + wu[1][e] * c1[e] + wu[2][e] * c0[e]; o[e] = siluf(gv) * uv; }
                u32x4 wv; wv.x = pk2(o[0], o[1]); wv.y = pk2(o[2], o[3]); wv.z = pk2(o[4], o[5]); wv.w = pk2(o[6], o[7]);
                *(u32x4*)(G2 + (size_t)(lr0 + i0 + i) * DFF + f0) = wv;
                g2 = g1; g1 = gc[i]; u2 = u1; u1 = uc[i];
            }
        }
    }
}

#define XB_TMO      128
#define XB_XCNT(j)  (256  + 64 * (j))
#define XB_XSUB(j)  (1280 + 64 * (j))
#define XB_XGEN(j)  (2304 + 64 * (j))
#define XB_TOP      3328
#define XB_TOPGEN   3392
#define XCD_BAR_WORDS 3456
#define XB_SPIN_CAP (1u << 18)

__device__ __forceinline__ unsigned xb_ld(unsigned* p)              { return __hip_atomic_load(p, __ATOMIC_RELAXED, __HIP_MEMORY_SCOPE_AGENT); }
__device__ __forceinline__ unsigned xb_add(unsigned* p, unsigned v) { return __hip_atomic_fetch_add(p, v, __ATOMIC_RELAXED, __HIP_MEMORY_SCOPE_AGENT); }
__device__ __forceinline__ unsigned xb_xcc_id() { return (unsigned)__builtin_amdgcn_s_getreg((3 << 11) | 20) & 0xFu; }
#define XB_SPIN(cond, bar) do { unsigned _sp = 0; while (cond) { __builtin_amdgcn_s_sleep(1); \
    if ((++_sp & 255u) == 0u) { if (xb_ld(&(bar)[XB_TMO])) break; if (_sp > XB_SPIN_CAP) { atomicAdd(&(bar)[XB_TMO], 1u); break; } } } } while (0)

struct XcdBarrier {
    unsigned* bar; unsigned x;
    volatile LAS unsigned* st;
};

__device__ __forceinline__ XcdBarrier xcd_barrier_post(unsigned* bar, volatile LAS unsigned* st) {
    XcdBarrier b; b.bar = bar; b.x = xb_xcc_id(); b.st = st;
    if (threadIdx.x == 0) (void)xb_add(&bar[XB_XCNT(b.x)], 1u);
    return b;
}
__device__ __forceinline__ void xcd_barrier_complete(unsigned* bar, unsigned x, unsigned& nloc, unsigned& nx) {
    const unsigned G = gridDim.x * gridDim.y * gridDim.z;
    unsigned sum, cnt, mine, sp = 0u;
    for (;;) {
        sum = 0u; cnt = 0u; mine = 0u;
#pragma unroll
        for (unsigned j = 0; j < 16; ++j) { const unsigned c = xb_ld(&bar[XB_XCNT(j)]); sum += c; cnt += (c > 0u) ? 1u : 0u; mine = (j == x) ? c : mine; }
        if (sum == G) break;
        __builtin_amdgcn_s_sleep(1);
        if ((++sp & 255u) == 0u) { if (xb_ld(&bar[XB_TMO])) break; if (sp > XB_SPIN_CAP) { atomicAdd(&bar[XB_TMO], 1u); break; } }
    }
    nloc = mine > 0u ? mine : 1u; nx = cnt > 0u ? cnt : 1u;
}

__device__ __forceinline__ void xcd_barrier(const XcdBarrier& b) {
    asm volatile("s_waitcnt vmcnt(0)" ::: "memory");
    __syncthreads();
    if (pg8::wg_tid((PG8_LAS unsigned char*)b.st - (LDS_BYTES - 16)) == 0) {
        unsigned* bar = b.bar;
        __builtin_amdgcn_s_waitcnt(0);
        unsigned nloc = b.st[0], nx = b.st[1];
        if (nloc == 0u) { xcd_barrier_complete(bar, b.x, nloc, nx); b.st[0] = nloc; b.st[1] = nx; }
        const unsigned old = xb_add(&bar[XB_XSUB(b.x)], 1u);
        const unsigned gen = old / nloc;
        if (old + 1u == (gen + 1u) * nloc) {
            __builtin_amdgcn_fence(__ATOMIC_RELEASE, "agent");
            asm volatile("s_waitcnt vmcnt(0)" ::: "memory");
            const unsigned og = xb_add(&bar[XB_TOP], 1u);
            const unsigned tg = og / nx;
            if (og + 1u == (tg + 1u) * nx) xb_add(&bar[XB_TOPGEN], 1u);
            else XB_SPIN(xb_ld(&bar[XB_TOPGEN]) == tg, bar);
            __builtin_amdgcn_fence(__ATOMIC_ACQUIRE, "agent");
            xb_add(&bar[XB_XGEN(b.x)], 1u);
            asm volatile("s_waitcnt vmcnt(0)" ::: "memory");
        } else {
            XB_SPIN(xb_ld(&bar[XB_XGEN(b.x)]) == gen, bar);
            __builtin_amdgcn_fence(__ATOMIC_ACQUIRE, "agent");
            asm volatile("s_waitcnt vmcnt(0)" ::: "memory");
        }
    }
    __syncthreads();
}

typedef float f32x16 __attribute__((ext_vector_type(16)));
template <int MODE, int NSEL> __device__ __forceinline__ void skinny_phase(const bf16_t* A, int lda, size_t asel, const bf16_t* Bt, size_t bsel, int K, int N, unsigned char* lds, int tid, int bx, int G,
                                                                          const bf16_t* GT, bf16_t* Ob, int ldo, bf16_t* H) {
    const int lane = tid & 63, w = tid >> 6, kw = K >> 3;
    float* red = (float*)lds;
    for (int blk = G - 1 - bx; blk < (N >> 5); blk += G) {
#pragma unroll
        for (int s = 0; s < NSEL; ++s) {
            const bf16_t* ap = A + s * asel + (size_t)(lane & 31) * lda + w * kw + 8 * (lane >> 5);
            const bf16_t* bp = Bt + s * bsel + (size_t)(blk * 32 + (lane & 31)) * K + w * kw + 8 * (lane >> 5);
            f32x16 acc;
#pragma unroll
            for (int i = 0; i < 16; ++i) acc[i] = 0.f;
#pragma unroll 8
            for (int k = 0; k < kw; k += 16) { const bf16x8 bv = *(const bf16x8*)(bp + k); const bf16x8 av = *(const bf16x8*)(ap + k); acc = __builtin_amdgcn_mfma_f32_32x32x16_bf16(bv, av, acc, 0, 0, 0); }
#pragma unroll
            for (int i = 0; i < 16; ++i) red[((s * 8 + w) * 16 + i) * 64 + lane] = acc[i];
        }
        __syncthreads();
        const int row = lane & 31, col = blk * 32 + 8 * (w >> 1) + 4 * (lane >> 5) + 2 * (w & 1);
        float v[NSEL][2];
#pragma unroll
        for (int s = 0; s < NSEL; ++s)
#pragma unroll
            for (int e = 0; e < 2; ++e) { float t = 0.f;
#pragma unroll
                for (int ww = 0; ww < 8; ++ww) t += red[((s * 8 + ww) * 16 + 2 * w + e) * 64 + lane]; v[s][e] = t; }
        if (MODE == 1) { *(unsigned*)(Ob + (size_t)row * ldo + col) = pk2(sigm(v[0][0]), sigm(v[0][1])); }
        else if (MODE == 2) { float o0 = 0.f, o1 = 0.f;
#pragma unroll
            for (int s = 0; s < NSEL; ++s) { const unsigned gwd = *(const unsigned*)(GT + (size_t)row * 6144 + s * 2048 + col); o0 += bflo(gwd) * v[s][0]; o1 += bfhi(gwd) * v[s][1]; }
            *(unsigned*)(Ob + (size_t)(MMAIN + row) * ldo + col) = pk2(o0, o1); }
        else if (MODE == 3) { unsigned* hp = (unsigned*)(H + (size_t)(MMAIN + row) * DM + col); const unsigned hw = *hp; *hp = pk2(bflo(hw) + v[0][0], bfhi(hw) + v[0][1]); }
        else { *(unsigned*)(Ob + (size_t)(16384 + row) * ldo + col) = pk2(v[0][0], v[0][1]); }
        __syncthreads();
    }
}

#ifndef GEMM_ALIGN
#define GEMM_ALIGN true
#endif
#ifndef GEMM_SP2
#define GEMM_SP2 true
#endif
#ifndef REP_ATT
#define REP_ATT 1
#endif
#ifndef REP_MIXB
#define REP_MIXB 1
#endif
#ifndef REP_SKIPSSD
#define REP_SKIPSSD 0
#endif
#ifndef REP_G1
#define REP_G1 1
#endif
#ifndef REP_MIXA
#define REP_MIXA 1
#endif
#ifndef REP_MEM
#define REP_MEM 1
#endif
#ifndef REP_SYNC
#define REP_SYNC 1
#endif
#define GSYNC() do { for (int rs_ = 0; rs_ < REP_SYNC; ++rs_) xcd_barrier(xbar); } while (0)
#ifndef PH_MASK
#define PH_MASK 0xFFFFF
#endif
#define PH(b) ((PH_MASK >> (b)) & 1)
typedef const __attribute__((address_space(4))) Ptrs* KPtr;
__global__ void __launch_bounds__(512, 2) fwd_megakernel(Ptrs Parg) {
    extern __shared__ __attribute__((aligned(16))) unsigned char lds[];
    cg::grid_group grid = cg::this_grid();
    constexpr int G = NGRID, NGW = NGRID * 8; const int bx = blockIdx.x;
    PG8_LAS unsigned char* glds = (PG8_LAS unsigned char*)lds;
    volatile LAS unsigned* misc = (volatile LAS unsigned*)((LAS unsigned char*)lds + (LDS_BYTES - 16));
    if (threadIdx.x < 4) misc[threadIdx.x] = 0u;
    if ((threadIdx.x & 63) == 0) { const unsigned hw = (unsigned)__builtin_amdgcn_s_getreg((5 << 11) | 4) & 63u; ((volatile LAS unsigned*)((LAS unsigned char*)lds + pg8::WMAP_OFF))[hw] = threadIdx.x >> 6; }
    __syncthreads();
    const XcdBarrier xbar = xcd_barrier_post((unsigned*)Parg.ws, misc);
    grid.sync();
#define TIDS const int tid = pg8::wg_tid(glds); const int lane = tid & 63, wave = tid >> 6, gw = bx * 8 + wave; (void)lane; (void)gw; (void)wave; PHP
#define PHP KPtr kp_ = (KPtr)__builtin_amdgcn_kernarg_segment_ptr(); asm volatile("" : "+s"(kp_)); Ptrs P; __builtin_memcpy(&P, (const void*)kp_, sizeof(Ptrs)); \
    unsigned char* dob = (unsigned char*)P.out; bf16_t* U = (bf16_t*)(P.ws + WS_U); bf16_t* PJ = (bf16_t*)(P.ws + WS_R); bf16_t* H = (bf16_t*)(P.ws + WS_H); \
    bf16_t* WinT = (bf16_t*)(dob + DO_WIN); bf16_t* WgT = (bf16_t*)(dob + DO_WG); bf16_t* WbT = (bf16_t*)(dob + DO_WB); bf16_t* WoT = (bf16_t*)(dob + DO_WO); \
    bf16_t* WupT = (bf16_t*)(dob + DO_WUP); bf16_t* WdT = (bf16_t*)(dob + DO_WD); bf16_t* GT = (bf16_t*)(P.ws + WS_X); \
    (void)U; (void)PJ; (void)H; (void)WinT; (void)WgT; (void)WbT; (void)WoT; (void)WupT; (void)WdT; (void)GT

    for (int l = 0; l < 2; ++l) {
        for (int rep = 0; rep < REP_MEM; ++rep) if (PH(0)) { TIDS; convert_weights(P, l, lds, gw, NGW, lane, wave); }
        for (int rep = 0; rep < REP_MEM; ++rep) if (PH(1)) { TIDS; if (l == 0) norm_phase<1>(P, P.attn_norm_w, gw, NGW, lane); else norm_phase<0>(P, P.attn_norm_w + l * DM, gw, NGW, lane); }
        GSYNC();
        for (int rep = 0; rep < REP_G1; ++rep) if (PH(2)) { PHP; pg8::Gemm g{U, WinT, DM, DM, 0, 0, 0}; pg8::Sched S{129, PW / 256, 1, G, bx, 0, 129};
          pg8::EpiStore<0> E{PJ, PW, 0};
          pg8::gemm_phase<pg8::EpiStore<0>, pg8::Sched, GEMM_ALIGN, GEMM_SP2>(glds, g, S, E); }
        if (PH(3)) { TIDS; dt_phase(P, gw, NGW, lane); }
        GSYNC();
        if (PH(4)) { TIDS; attn_tables(P, lds, tid);
          unsigned* qctr = (unsigned*)P.ws + 8192 + 64 * (2 * l);
          unsigned nxt = 0u; if (tid == 0) misc[2] = atomicAdd(qctr, 1u);
          __syncthreads();
          int it = (int)__builtin_amdgcn_readfirstlane(misc[2]);
          while (it < 28 * NCH) { const int t2 = pg8::wg_tid(glds);
              if (t2 == 0) nxt = atomicAdd(qctr, 1u);
              if (it < 16 * NCH) { const int ch = it % NCH, bh = it / NCH; hg_unit(P, l, bh >> 3, bh & 7, ch, lds, t2); }
              else if (it < 24 * NCH) { const int i2 = it - 16 * NCH; const int ch = i2 % NCH, bg = i2 / NCH; ssd_passA(P, l, bg >> 2, ch, bg & 3, lds, t2); }
              else { const int i2 = it - 24 * NCH; const int n = i2 % NCH, bg = i2 / NCH; attn_unit(P, l, bg >> 1, bg & 1, n, lds, t2, true); }
              if (t2 == 0) misc[2] = nxt;
              __syncthreads();
              it = (int)__builtin_amdgcn_readfirstlane(misc[2]); } }
        GSYNC();
        if (PH(7)) { TIDS; scan_phase(P, tid); }
        GSYNC();
        if (PH(8)) { TIDS;
          unsigned* qctr = (unsigned*)P.ws + 8192 + 64 * (2 * l + 1);
          unsigned nxt = 0u; if (tid == 0) misc[2] = atomicAdd(qctr, 1u);
          __syncthreads();
          int it = (int)__builtin_amdgcn_readfirstlane(misc[2]);
          while (it < 24 * NCH) { const int t2 = pg8::wg_tid(glds);
              if (t2 == 0) nxt = atomicAdd(qctr, 1u);
              if (it < 8 * NCH) { const int ch = it % NCH, bg = it / NCH; ssd_passB(P, l, bg >> 2, ch, bg & 3, lds, t2, true); }
              else { const int i2 = it - 8 * NCH; const int ch = i2 % NCH, bh = i2 / NCH; hg_passB(P, l, bh >> 3, bh & 7, ch, lds, t2, true); }
              if (t2 == 0) misc[2] = nxt;
              __syncthreads();
              it = (int)__builtin_amdgcn_readfirstlane(misc[2]); } }
        GSYNC();
        if (PH(10)) { PHP; pg8::Gemm g{U, WgT, DM, DM, 0, 0, 0}; pg8::Sched S{128, 24, 1, G, bx, 0, 128};
          pg8::EpiGate E{pg8::GateMap{PJ + C_HQ, GT, (bf16_t*)(dob + DO_GB)}};
          pg8::gemm_phase<pg8::EpiGate, pg8::Sched, GEMM_ALIGN, GEMM_SP2>(glds, g, S, E); }
        { TIDS; skinny_phase<1, 1>(U + (size_t)MMAIN * DM, DM, 0, WgT, 0, DM, 6144, lds, tid, bx, G, nullptr, (bf16_t*)(dob + DO_GMETA), 6144, nullptr); }
        GSYNC();
        if (PH(11)) { PHP; pg8::Gemm g{PJ + C_AQ, WbT, 1024, PW, 0, (size_t)1024, (size_t)DM * 1024}; pg8::Sched S{128, 8, 3, G, bx, 0, 128};
          pg8::EpiMerge E{pg8::GateMap{PJ + C_HQ, GT, (bf16_t*)(dob + DO_GB)}, PJ + C_XBC, PW};
          pg8::gemm_phase<pg8::EpiMerge, pg8::Sched, GEMM_ALIGN, GEMM_SP2>(glds, g, S, E); }
        { TIDS; skinny_phase<2, 3>(PJ + (size_t)MMAIN * PW + C_AQ, PW, 1024, WbT, (size_t)DM * 1024, 1024, DM, lds, tid, bx, G, (const bf16_t*)(dob + DO_GMETA), PJ + C_XBC, PW, nullptr); }
        GSYNC();
        if (PH(12)) { PHP; pg8::Gemm g{PJ + C_XBC, WoT, DM, PW, 0, 0, 0}; pg8::Sched S{128, 8, 1, G, bx, 0, 128};
          pg8::EpiResid E{H};
          pg8::gemm_phase<pg8::EpiResid, pg8::Sched, GEMM_ALIGN, GEMM_SP2>(glds, g, S, E); }
        { TIDS; skinny_phase<3, 1>(PJ + (size_t)MMAIN * PW + C_XBC, PW, 0, WoT, 0, DM, DM, lds, tid, bx, G, nullptr, nullptr, 0, H); }
        GSYNC();
        if (PH(13)) { TIDS; norm_phase<0>(P, P.ffn_norm_w + l * DM, gw, NGW, lane); }
        GSYNC();
        for (int half = 0; half < 2; ++half) {
            if (PH(14)) { PHP; bf16_t* A2 = PJ; pg8::Gemm g{U, WupT, DM, DM, 0, 0, 0}; pg8::Sched S{64, 44, 1, G, bx, 64 * half, 64};
              pg8::EpiStore<0> E{A2, 11264, 1};
              pg8::gemm_phase<pg8::EpiStore<0>, pg8::Sched, GEMM_ALIGN, GEMM_SP2>(glds, g, S, E); }
            if (half == 0) { TIDS; skinny_phase<4, 1>(U + (size_t)MMAIN * DM, DM, 0, WupT, 0, DM, 2 * DFF, lds, tid, bx, G, nullptr, PJ, 2 * DFF, nullptr); }
            GSYNC();
            for (int rep = 0; rep < REP_MEM; ++rep) if (PH(15)) { TIDS; ffn_act_phase(P, l, half, gw, NGW, lane); }
            GSYNC();
            if (PH(16)) { PHP; bf16_t* G2 = (bf16_t*)(P.ws + WS_R + (size_t)16640 * 11264 * 2); pg8::Gemm g{G2, WdT, DFF, DFF, 1, 0, 0}; pg8::Sched S{64, 8, 1, G, bx, 64 * half, 64};
              pg8::EpiResid E{H};
              pg8::gemm_phase<pg8::EpiResid, pg8::Sched, GEMM_ALIGN, GEMM_SP2>(glds, g, S, E); }
            if (half == 1) { TIDS; skinny_phase<3, 1>((const bf16_t*)(P.ws + WS_R + (size_t)16640 * 11264 * 2) + (size_t)16384 * DFF, DFF, 0, WdT, 0, DFF, DM, lds, tid, bx, G, nullptr, nullptr, 0, H); }
            GSYNC();
        }
    }
    if (PH(17)) { TIDS; norm_phase<2>(P, P.final_norm_w, gw, NGW, lane); }
}

extern "C" void kernel_launch(void* const* d_in, const int* in_sizes, int n_in, void* d_out, int out_size, void* d_ws, size_t ws_size, hipStream_t stream) {
    static int grid = 0;
    if (grid == 0) {
        if (n_in != 22 || ws_size < WS_NEED) { fprintf(stderr, "kernel_launch: unexpected n_in %d or workspace %zu < %zu\n", n_in, ws_size, (size_t)WS_NEED); grid = -1; return; }
        int dev = 0, cus = 0, per_cu = 0;
        hipGetDevice(&dev); hipDeviceGetAttribute(&cus, hipDeviceAttributeMultiprocessorCount, dev);
        if (hipFuncSetAttribute((const void*)fwd_megakernel, hipFuncAttributeMaxDynamicSharedMemorySize, LDS_BYTES) != hipSuccess) { fprintf(stderr, "hipFuncSetAttribute failed\n"); }
        if (hipOccupancyMaxActiveBlocksPerMultiprocessor(&per_cu, (const void*)fwd_megakernel, 512, LDS_BYTES) != hipSuccess || per_cu < 1) per_cu = 1;
        (void)hipGetLastError();
        grid = NGRID; if (cus < NGRID) { fprintf(stderr, "kernel_launch: built for %d CUs, device has %d\n", NGRID, cus); grid = -1; return; }
    }
    if (grid < 0) return;
    if (hipMemsetAsync(d_ws, 0, 65536, stream) != hipSuccess) { fprintf(stderr, "memset failed\n"); return; }
    Ptrs p{};
    const float** pp = (const float**)&p;
    for (int i = 0; i < 22; ++i) pp[i] = (const float*)d_in[i];
    p.out = (float*)d_out; p.ws = (unsigned char*)d_ws;
    void* args[] = {&p};
    hipError_t e = hipLaunchCooperativeKernel((const void*)fwd_megakernel, dim3(grid), dim3(512), args, LDS_BYTES, stream);
    if (e != hipSuccess) fprintf(stderr, "cooperative launch failed: %s (grid %d)\n", hipGetErrorString(e), grid);
}
```

```cpp
#include <hip/hip_runtime.h>
#include <hip/hip_cooperative_groups.h>
#include <cstdio>
#include <cstdint>
namespace cg = cooperative_groups;

namespace pg8 {
#define PG8_LAS __attribute__((address_space(3)))
constexpr int WMAP_OFF = 163840 - 16 - 256;
__device__ __forceinline__ int wg_tid(PG8_LAS unsigned char* ldsbase) {
    const unsigned hw = (unsigned)__builtin_amdgcn_s_getreg((5 << 11) | 4) & 63u;
    const unsigned wv = ((volatile PG8_LAS unsigned*)(ldsbase + WMAP_OFF))[hw];
    const int lane = (int)__builtin_amdgcn_mbcnt_hi(~0u, __builtin_amdgcn_mbcnt_lo(~0u, 0u));
    int t = (int)__builtin_amdgcn_readfirstlane(wv) * 64 + lane;
    asm volatile("" : "+v"(t));
    return t;
}
typedef unsigned short bf16_t;
typedef short bf16x8 __attribute__((ext_vector_type(8)));
typedef float f32x4 __attribute__((ext_vector_type(4)));
typedef unsigned u32x4 __attribute__((ext_vector_type(4)));
constexpr int BM = 256, BK = 64, HALF = 128, HTB = HALF * BK * 2, STAGE_BYTES = 8 * HTB, NXCD = 8, WGM = 8;

__host__ __device__ __forceinline__ int lds_byte(int r, int c) { const int st = (r >> 4) * 2 + (c >> 5), rr = r & 15, cc = c & 31, ob = rr * 64 + cc * 2; return st * 1024 + (ob ^ (((ob >> 9) & 1) << 5)); }
__host__ __device__ __forceinline__ void stage_rc(int b, int& R, int& C) { const int st = b / 1024, sb = b % 1024, swz = sb ^ (((sb >> 9) & 1) << 5); R = (st >> 1) * 16 + swz / 64; C = (st & 1) * 32 + (swz % 64) / 2; }
__host__ __device__ __forceinline__ int perm32(int rho) { const int n = rho >> 4, i = rho & 15; return 8 * (i >> 2) + 4 * n + (i & 3); }

struct Unit { int pm, pn, sel, lpm; };
struct Gemm { const bf16_t* A; const bf16_t* Bt; int K, lda, alocal; size_t asel, bsel; };

struct Sched {
    int nM, nN, nsel, G, c, pm0, nMain;
    __device__ __forceinline__ bool next(int i, Unit& u) const {
        const int nwg = nM * nN; const int L = (i / nsel) * G + c; if (L >= nwg) return false;
        int wgid = L; { const int q = nwg / NXCD, r = nwg % NXCD, xcd = wgid % NXCD, off = wgid / NXCD; wgid = (xcd < r ? xcd * (q + 1) : r * (q + 1) + (xcd - r) * q) + off; }
        const int nig = WGM * nN, gid = wgid / nig, fm = gid * WGM, gsz = (nM - fm) < WGM ? (nM - fm) : WGM;
        u.lpm = fm + ((wgid % nig) % gsz); u.pn = (wgid % nig) / gsz; u.sel = i % nsel; u.pm = (u.lpm < nMain) ? (pm0 + u.lpm) : 128; return true;
    }
    __device__ __forceinline__ void a_ready(const Unit&) const {}
    __device__ __forceinline__ void done(const Unit&) const {}
};
typedef float f32x2_t __attribute__((ext_vector_type(2))); typedef __bf16 bf16x2_t __attribute__((ext_vector_type(2)));
__device__ __forceinline__ unsigned pk2_(float lo, float hi) { f32x2_t v = {lo, hi}; bf16x2_t b = __builtin_convertvector(v, bf16x2_t); return __builtin_bit_cast(unsigned, b); }
__device__ __forceinline__ float bflo(unsigned w) { return __builtin_bit_cast(float, w << 16); }
__device__ __forceinline__ float bfhi(unsigned w) { return __builtin_bit_cast(float, w & 0xffff0000u); }
__device__ __forceinline__ float sigm(float x) { return __builtin_amdgcn_rcpf(1.0f + __expf(-x)); }

__device__ __forceinline__ void store16_wt(void* p, u32x4 v) { asm volatile("global_store_dwordx4 %0, %1, off sc1\n\ts_nop 1" :: "v"(p), "v"(v) : "memory"); }
template <int ACT  > struct EpiStore {
    static constexpr bool PERM = true, AFTER_DRAIN = false;
    bf16_t* O; int ldc; int local;
    __device__ __forceinline__ void operator()(const f32x4 (&acc)[2][2][4][2], const Unit& u, int wr, int wc, int fr, int fq) const {
        const int row0 = (local ? u.lpm : u.pm) * BM + wr * 64 + fr; const int col0 = u.pn * BM + wc * 32 + 8 * fq;
#pragma unroll
        for (int ai = 0; ai < 2; ++ai)
#pragma unroll
            for (int m = 0; m < 4; ++m) { bf16_t* rowp = O + (size_t)(row0 + ai * HALF + m * 16) * ldc + col0;
#pragma unroll
                for (int bj = 0; bj < 2; ++bj) { f32x4 v0 = acc[ai][bj][m][0], v1 = acc[ai][bj][m][1];
                    if (ACT == 1) { v0 = (f32x4){sigm(v0[0]), sigm(v0[1]), sigm(v0[2]), sigm(v0[3])}; v1 = (f32x4){sigm(v1[0]), sigm(v1[1]), sigm(v1[2]), sigm(v1[3])}; }
                    u32x4 w; w.x = pk2_(v0[0], v0[1]); w.y = pk2_(v0[2], v0[3]); w.z = pk2_(v1[0], v1[1]); w.w = pk2_(v1[2], v1[3]);
                    store16_wt(rowp + bj * HALF, w); } }
    }
};
struct GateMap { bf16_t* PJg; bf16_t* Xa; bf16_t* Xb;
    __device__ __forceinline__ bf16_t* at(int pm, int rl, int gt  , int c) const {
        if (gt < 12) return PJg + (size_t)(pm * BM + rl) * 8448 + gt * BM + c;
        return (pm < 64 ? Xa + (size_t)(pm * BM + rl) * 3072 : Xb + (size_t)((pm - 64) * BM + rl) * 3072) + (gt - 12) * BM + c; } };
struct EpiGate {
    static constexpr bool PERM = true, AFTER_DRAIN = false;
    GateMap gm;
    __device__ __forceinline__ void operator()(const f32x4 (&acc)[2][2][4][2], const Unit& u, int wr, int wc, int fr, int fq) const {
        const int c0 = wc * 32 + 8 * fq;
#pragma unroll
        for (int ai = 0; ai < 2; ++ai)
#pragma unroll
            for (int m = 0; m < 4; ++m) { bf16_t* rowp = gm.at(u.pm, wr * 64 + fr + ai * HALF + m * 16, u.pn, c0);
#pragma unroll
                for (int bj = 0; bj < 2; ++bj) { const f32x4 v0 = acc[ai][bj][m][0], v1 = acc[ai][bj][m][1];
                    u32x4 w; w.x = pk2_(sigm(v0[0]), sigm(v0[1])); w.y = pk2_(sigm(v0[2]), sigm(v0[3])); w.z = pk2_(sigm(v1[0]), sigm(v1[1])); w.w = pk2_(sigm(v1[2]), sigm(v1[3]));
                    store16_wt(rowp + bj * HALF, w); } }
    }
};
struct EpiMerge {
    static constexpr bool PERM = true, AFTER_DRAIN = false;
    GateMap gm; bf16_t* Mg; int ldm;
    __device__ __forceinline__ void operator()(const f32x4 (&acc)[2][2][4][2], const Unit& u, int wr, int wc, int fr, int fq) const {
        const int col0 = u.pn * BM + wc * 32 + 8 * fq;
#pragma unroll
        for (int ai = 0; ai < 2; ++ai) {
            u32x4 gw[4][2], ow[4][2];
#pragma unroll
            for (int m = 0; m < 4; ++m) { const int rl = wr * 64 + fr + ai * HALF + m * 16;
                const bf16_t* gp = gm.at(u.pm, rl, u.sel * 8 + u.pn, wc * 32 + 8 * fq); const bf16_t* mp2 = Mg + (size_t)(u.pm * BM + rl) * ldm + col0;
#pragma unroll
                for (int bj = 0; bj < 2; ++bj) { gw[m][bj] = *(const u32x4*)(gp + bj * HALF); ow[m][bj] = (u32x4){0u, 0u, 0u, 0u}; if (u.sel > 0) ow[m][bj] = *(const u32x4*)(mp2 + bj * HALF); } }
#pragma unroll
            for (int m = 0; m < 4; ++m) { const int rl = wr * 64 + fr + ai * HALF + m * 16; bf16_t* mp2 = Mg + (size_t)(u.pm * BM + rl) * ldm + col0;
#pragma unroll
                for (int bj = 0; bj < 2; ++bj) { const f32x4 v0 = acc[ai][bj][m][0], v1 = acc[ai][bj][m][1]; const u32x4 g = gw[m][bj], o = ow[m][bj];
                    u32x4 w; w.x = pk2_(bflo(o.x) + bflo(g.x) * v0[0], bfhi(o.x) + bfhi(g.x) * v0[1]); w.y = pk2_(bflo(o.y) + bflo(g.y) * v0[2], bfhi(o.y) + bfhi(g.y) * v0[3]);
                    w.z = pk2_(bflo(o.z) + bflo(g.z) * v1[0], bfhi(o.z) + bfhi(g.z) * v1[1]); w.w = pk2_(bflo(o.w) + bflo(g.w) * v1[2], bfhi(o.w) + bfhi(g.w) * v1[3]);
                    *(u32x4*)(mp2 + bj * HALF) = w; } }
            asm volatile("" ::: "memory");
        }
    }
};
struct EpiResid {
    static constexpr bool PERM = false, AFTER_DRAIN = false;
    bf16_t* H;
    __device__ __forceinline__ void operator()(const f32x4 (&acc)[2][2][4][2], const Unit& u, int wr, int wc, int fr, int fq) const {
        typedef unsigned u32x2_ __attribute__((ext_vector_type(2)));
        const int col0 = u.pn * BM + wc * 32 + 4 * fq;
#pragma unroll
        for (int ai = 0; ai < 2; ++ai) {
            u32x2_ v[4][2][2];
#pragma unroll
            for (int m = 0; m < 4; ++m) { const bf16_t* rowp = H + (size_t)(u.pm * BM + wr * 64 + fr + ai * HALF + m * 16) * 2048 + col0;
#pragma unroll
                for (int bj = 0; bj < 2; ++bj)
#pragma unroll
                    for (int n = 0; n < 2; ++n) v[m][bj][n] = *(const u32x2_*)(rowp + bj * HALF + n * 16); }
#pragma unroll
            for (int m = 0; m < 4; ++m) { bf16_t* rowp = H + (size_t)(u.pm * BM + wr * 64 + fr + ai * HALF + m * 16) * 2048 + col0;
#pragma unroll
                for (int bj = 0; bj < 2; ++bj)
#pragma unroll
                    for (int n = 0; n < 2; ++n) { const f32x4 a = acc[ai][bj][m][n]; const u32x2_ o = v[m][bj][n];
                        u32x2_ w; w.x = pk2_(bflo(o.x) + a[0], bfhi(o.x) + a[1]); w.y = pk2_(bflo(o.y) + a[2], bfhi(o.y) + a[3]); *(u32x2_*)(rowp + bj * HALF + n * 16) = w; } }
            asm volatile("" ::: "memory");
        }
    }
};

template <class Epi, class Sched, bool ALIGN_EPI = false, bool SP2 = false>
__device__ __forceinline__ void gemm_phase(PG8_LAS unsigned char* lds, const Gemm g, const Sched& S, const Epi& E) {
    const int tid0_ = wg_tid(lds);
    const int tid = tid0_, wid = __builtin_amdgcn_readfirstlane(tid >> 6), lane = tid & 63, wr = wid >> 2, wc = wid & 3, fr = lane & 15, fq = lane >> 4;
    const int K = g.K, nt = K / BK, lda = g.lda;
    unsigned voffA[2], voffB[2];
#pragma unroll
    for (int i = 0; i < 2; ++i) { int R, C; stage_rc(tid * 16 + i * 8192, R, C); const int Rb = Epi::PERM ? ((R & ~31) + perm32(R & 31)) : R;
        voffA[i] = (unsigned)(R * lda + C) * 2u; voffB[i] = (unsigned)(Rb * K + C) * 2u; }
    const size_t kstep = (size_t)(BK * 2);
    const size_t hstepA = (size_t)HALF * lda * 2, hstepB = (size_t)HALF * K * 2;
    const unsigned ldsw = (unsigned)wid * 1024u;
    const int aoff = lds_byte(wr * 64 + fr, fq * 8), boff = lds_byte(wc * 32 + fr, fq * 8);
#define PG8_SA(b, h) (((b) * 2 + (h)) * HTB)
#define PG8_SB(b, h) ((4 + (b) * 2 + (h)) * HTB)
#define PG8_STAGE(bufoff, gbase, voff) do { _Pragma("unroll") for (int _i = 0; _i < 2; ++_i) \
        __builtin_amdgcn_global_load_lds((const unsigned*)((const char*)(gbase) + (voff)[_i]), (PG8_LAS unsigned*)(lds + (bufoff) + ldsw + _i * 8192), 16, 0, 0); } while (0)
#define PG8_LDA(dst, b, h) do { _Pragma("unroll") for (int m = 0; m < 4; ++m) _Pragma("unroll") for (int k = 0; k < 2; ++k) dst[m][k] = *(const PG8_LAS bf16x8*)(lds + PG8_SA(b, h) + aoff + m * 2048 + k * 1024); } while (0)
#define PG8_LDB(dst, b, h) do { _Pragma("unroll") for (int n = 0; n < 2; ++n) _Pragma("unroll") for (int k = 0; k < 2; ++k) dst[n][k] = *(const PG8_LAS bf16x8*)(lds + PG8_SB(b, h) + boff + n * 2048 + k * 1024); } while (0)
#define PG8_MMA(ai, bj, At, Bt) do { __builtin_amdgcn_s_setprio(1); _Pragma("unroll") for (int m = 0; m < 4; ++m) _Pragma("unroll") for (int n = 0; n < 2; ++n) _Pragma("unroll") for (int k = 0; k < 2; ++k) \
        acc[ai][bj][m][n] = __builtin_amdgcn_mfma_f32_16x16x32_bf16(Bt[n][k], At[m][k], acc[ai][bj][m][n], 0, 0, 0); __builtin_amdgcn_s_setprio(0); } while (0)
#define PG8_WAIT_V(n) asm volatile("s_waitcnt vmcnt(" #n ")" ::: "memory")
#define PG8_WAIT_L(n) asm volatile("s_waitcnt lgkmcnt(" #n ")" ::: "memory")
#define PG8_BAR __builtin_amdgcn_s_barrier()
#define PG8_SCHED __builtin_amdgcn_sched_barrier(0)
#define PG8_UA(u) ((const char*)g.A + ((size_t)(g.alocal ? (u).lpm : (u).pm) * 256 * (size_t)lda + (size_t)(u).sel * g.asel) * 2)
#define PG8_UB(u) ((const char*)g.Bt + ((size_t)(u).pn * 256 * (size_t)K + (size_t)(u).sel * g.bsel) * 2)
    Unit cur, nxt; int ui = 0;
    if (!S.next(0, cur)) return;
    f32x4 acc[2][2][4][2];
#pragma unroll
    for (int a = 0; a < 2; ++a)
#pragma unroll
        for (int b = 0; b < 2; ++b)
#pragma unroll
            for (int m = 0; m < 4; ++m)
#pragma unroll
                for (int n = 0; n < 2; ++n) acc[a][b][m][n] = (f32x4){0.f, 0.f, 0.f, 0.f};
    bf16x8 At[4][2], B0[2][2], B1[2][2];
    const char* cA = PG8_UA(cur); const char* cB = PG8_UB(cur);
    S.a_ready(cur);
    if constexpr (SP2) {
        PG8_STAGE(PG8_SB(0, 0), cB, voffB); PG8_STAGE(PG8_SB(0, 1), cB + hstepB, voffB); PG8_STAGE(PG8_SA(0, 0), cA, voffA); PG8_STAGE(PG8_SA(0, 1), cA + hstepA, voffA);
        if (wr == 1) PG8_BAR;
        PG8_WAIT_V(2); PG8_BAR;
        PG8_STAGE(PG8_SB(1, 0), cB + kstep, voffB); PG8_STAGE(PG8_SA(1, 0), cA + kstep, voffA); PG8_STAGE(PG8_SB(1, 1), cB + hstepB + kstep, voffB);
        PG8_WAIT_V(6); PG8_BAR;
    } else {
        PG8_STAGE(PG8_SB(0, 0), cB, voffB); PG8_STAGE(PG8_SA(0, 0), cA, voffA); PG8_STAGE(PG8_SB(0, 1), cB + hstepB, voffB); PG8_STAGE(PG8_SA(0, 1), cA + hstepA, voffA);
        if (wr == 1) PG8_BAR;
        PG8_WAIT_V(4); PG8_BAR;
        PG8_STAGE(PG8_SB(1, 0), cB + kstep, voffB); PG8_STAGE(PG8_SA(1, 0), cA + kstep, voffA); PG8_STAGE(PG8_SB(1, 1), cB + hstepB + kstep, voffB);
        PG8_WAIT_V(6); PG8_BAR;
    }
    for (;;) {
        const bool has_next = S.next(ui + 1, nxt);
        const char* nA = has_next ? PG8_UA(nxt) : cA; const char* nB = has_next ? PG8_UB(nxt) : cB;
        for (int t = 0; t < nt; t += 2) {
            const bool last = (t == nt - 2);
            const char* a1 = cA + (size_t)(t + 1) * kstep;
            const char* a2 = last ? nA : cA + (size_t)(t + 2) * kstep; const char* b2 = last ? nB : cB + (size_t)(t + 2) * kstep;
            const char* a3 = a2 + kstep; const char* b3 = b2 + kstep;
            if (last && has_next) S.a_ready(nxt);
            if constexpr (SP2) {
            PG8_LDB(B0, 0, 0); PG8_LDB(B1, 0, 1); PG8_SCHED; PG8_LDA(At, 0, 0); PG8_STAGE(PG8_SA(1, 1), a1 + hstepA, voffA);
            PG8_WAIT_V(8); PG8_WAIT_L(0); PG8_BAR; PG8_MMA(0, 0, At, B0); PG8_MMA(0, 1, At, B1); PG8_BAR; PG8_SCHED;
            PG8_LDA(At, 0, 1); PG8_STAGE(PG8_SB(0, 0), b2, voffB); PG8_STAGE(PG8_SB(0, 1), b2 + hstepB, voffB); PG8_STAGE(PG8_SA(0, 0), a2, voffA);
            PG8_WAIT_V(8); PG8_WAIT_L(0); PG8_BAR; PG8_MMA(1, 0, At, B0); PG8_MMA(1, 1, At, B1); PG8_BAR; PG8_SCHED;
            PG8_LDB(B0, 1, 0); PG8_LDB(B1, 1, 1); PG8_SCHED; PG8_LDA(At, 1, 0); PG8_STAGE(PG8_SA(0, 1), a2 + hstepA, voffA);
            PG8_WAIT_V(8); PG8_WAIT_L(0); PG8_BAR; PG8_MMA(0, 0, At, B0); PG8_MMA(0, 1, At, B1); PG8_BAR; PG8_SCHED;
            PG8_LDA(At, 1, 1); PG8_STAGE(PG8_SB(1, 0), b3, voffB); PG8_STAGE(PG8_SB(1, 1), b3 + hstepB, voffB); PG8_STAGE(PG8_SA(1, 0), a3, voffA);
            PG8_WAIT_V(8); PG8_WAIT_L(0); PG8_BAR; PG8_MMA(1, 0, At, B0); PG8_MMA(1, 1, At, B1); PG8_BAR; PG8_SCHED;
            } else {
            PG8_LDB(B0, 0, 0); PG8_SCHED; PG8_LDA(At, 0, 0); PG8_STAGE(PG8_SA(1, 1), a1 + hstepA, voffA);
            PG8_WAIT_L(8); PG8_BAR; PG8_WAIT_L(0); PG8_MMA(0, 0, At, B0); PG8_BAR; PG8_SCHED;
            PG8_LDB(B1, 0, 1); PG8_STAGE(PG8_SB(0, 0), b2, voffB);
            PG8_BAR; PG8_WAIT_L(0); PG8_MMA(0, 1, At, B1); PG8_BAR;
            PG8_LDA(At, 0, 1); PG8_STAGE(PG8_SA(0, 0), a2, voffA);
            PG8_BAR; PG8_WAIT_L(0); PG8_MMA(1, 0, At, B0); PG8_BAR; PG8_SCHED;
            PG8_STAGE(PG8_SB(0, 1), b2 + hstepB, voffB);
            PG8_WAIT_V(6); PG8_BAR; PG8_MMA(1, 1, At, B1); PG8_BAR;
            PG8_LDB(B0, 1, 0); PG8_SCHED; PG8_LDA(At, 1, 0); PG8_STAGE(PG8_SA(0, 1), a2 + hstepA, voffA);
            PG8_WAIT_L(8); PG8_BAR; PG8_WAIT_L(0); PG8_MMA(0, 0, At, B0); PG8_BAR; PG8_SCHED;
            PG8_LDB(B1, 1, 1); PG8_STAGE(PG8_SB(1, 0), b3, voffB);
            PG8_BAR; PG8_WAIT_L(0); PG8_MMA(0, 1, At, B1); PG8_BAR;
            PG8_LDA(At, 1, 1); PG8_STAGE(PG8_SA(1, 0), a3, voffA);
            PG8_BAR; PG8_WAIT_L(0); PG8_MMA(1, 0, At, B0); PG8_BAR; PG8_SCHED;
            PG8_STAGE(PG8_SB(1, 1), b3 + hstepB, voffB);
            PG8_WAIT_V(6); PG8_BAR; PG8_MMA(1, 1, At, B1); PG8_BAR;
            }
        }
        if constexpr (ALIGN_EPI) { if (wr == 0) PG8_BAR; }
        if constexpr (!Epi::AFTER_DRAIN) { E(acc, cur, wr, wc, fr, fq); S.done(cur); }
        if (!has_next) break;
#pragma unroll
        for (int a = 0; a < 2; ++a)
#pragma unroll
            for (int b = 0; b < 2; ++b)
#pragma unroll
                for (int m = 0; m < 4; ++m)
#pragma unroll
                    for (int n = 0; n < 2; ++n) acc[a][b][m][n] = (f32x4){0.f, 0.f, 0.f, 0.f};
        cur = nxt; cA = nA; cB = nB; ++ui;
        if constexpr (ALIGN_EPI) { if (wr == 1) PG8_BAR; }
    }
    PG8_WAIT_V(0);
    if constexpr (!ALIGN_EPI) { if (wr == 0) PG8_BAR; }
    PG8_BAR;
    if constexpr (Epi::AFTER_DRAIN) { E.fused(acc, cur, wr, wc, fr, fq, lds, wid, lane); S.done(cur); }
#undef PG8_SA
#undef PG8_SB
#undef PG8_STAGE
#undef PG8_LDA
#undef PG8_LDB
#undef PG8_MMA
#undef PG8_WAIT_V
#undef PG8_WAIT_L
#undef PG8_BAR
#undef PG8_SCHED
#undef PG8_UA
#undef PG8_UB
}
}

typedef unsigned short bf16_t;
typedef short bf16x8 __attribute__((ext_vector_type(8)));
typedef short bf16x4 __attribute__((ext_vector_type(4)));
typedef float f32x4 __attribute__((ext_vector_type(4)));
typedef unsigned u32x4 __attribute__((ext_vector_type(4)));
typedef unsigned u32x2 __attribute__((ext_vector_type(2)));
#define LAS __attribute__((address_space(3)))

constexpr int DM = 2048, NB = 2, SEQ = 16384, NMETA = 16, MMAIN = NB * SEQ, MTOK = MMAIN + NB * NMETA, MPAD = 33024;
constexpr int DIN = 14608, DFF = 5632, PW = 8448;
constexpr int C_AQ = 0, C_SZ = 1024, C_HG = 2048, C_AK = 3072, C_AV = 3200, C_XBC = 3328, C_HQ = 5376, C_HF = 6400, C_HI = 7424;
constexpr int NCH = 129;
constexpr float EPS = 1e-6f, NEGV = -1e30f;
constexpr size_t MiB = 1u << 20;
constexpr size_t WS_H = 1 * MiB, WS_U = 259 * MiB, WS_R = 388 * MiB, WS_X = 921 * MiB, WS_NEED = 1024 * MiB;
constexpr size_t DO_WIN = 0, DO_WG = 33 * MiB, DO_WB = 57 * MiB, DO_WO = 69 * MiB, DO_WUP = 77 * MiB, DO_WD = 121 * MiB, DO_WDT = 143 * MiB,
                 DO_HGS = 144 * MiB, DO_HGDEC = 209 * MiB, DO_DTRAW = 211 * MiB, DO_SSDDEC = 214 * MiB,
                 DO_GB = 144 * MiB  , DO_GMETA = 242 * MiB;
constexpr int LDS_BYTES = 163840, NGRID = 256;

__device__ __forceinline__ float bf2f(bf16_t v) { return __builtin_bit_cast(float, (unsigned)v << 16); }
typedef float f32x2_t __attribute__((ext_vector_type(2))); typedef __bf16 bf16x2_t __attribute__((ext_vector_type(2)));
__device__ __forceinline__ unsigned pk2(float lo, float hi) { f32x2_t v = {lo, hi}; bf16x2_t b = __builtin_convertvector(v, bf16x2_t); return __builtin_bit_cast(unsigned, b); }
__device__ __forceinline__ unsigned f2bf(float f) { return pk2(f, 0.f) & 0xffffu; }
__device__ __forceinline__ float bflo(unsigned w) { return __builtin_bit_cast(float, w << 16); }
__device__ __forceinline__ float bfhi(unsigned w) { return __builtin_bit_cast(float, w & 0xffff0000u); }
__device__ __forceinline__ float sigm(float x) { return __builtin_amdgcn_rcpf(1.0f + __expf(-x)); }
__device__ __forceinline__ float siluf(float x) { return x * __builtin_amdgcn_rcpf(1.0f + __expf(-x)); }
__device__ __forceinline__ int tok_row(int b, int t) { return t < NMETA ? (MMAIN + b * NMETA + t) : (b * SEQ + t - NMETA); }
__device__ __forceinline__ float shx(float v, int o, int lane) { return __builtin_bit_cast(float, __builtin_amdgcn_ds_bpermute((lane ^ o) << 2, __builtin_bit_cast(int, v))); }
__device__ __forceinline__ float wave_sum(float v, int lane) {
#pragma unroll
    for (int o = 1; o < 64; o <<= 1) v += shx(v, o, lane);
    return v;
}
__device__ __forceinline__ void unpack8(const u32x4 w, float* f) { f[0] = bflo(w.x); f[1] = bfhi(w.x); f[2] = bflo(w.y); f[3] = bfhi(w.y); f[4] = bflo(w.z); f[5] = bfhi(w.z); f[6] = bflo(w.w); f[7] = bfhi(w.w); }
__device__ __forceinline__ f32x4 mfma32(bf16x8 a, bf16x8 b, f32x4 c) { return __builtin_amdgcn_mfma_f32_16x16x32_bf16(a, b, c, 0, 0, 0); }
__device__ __forceinline__ f32x4 mfma16(bf16x4 a, bf16x4 b, f32x4 c) { return __builtin_amdgcn_mfma_f32_16x16x16bf16_1k(a, b, c, 0, 0, 0); }
__device__ __forceinline__ bf16x4 pack4(f32x4 v) { u32x2 w; w.x = pk2(v[0], v[1]); w.y = pk2(v[2], v[3]); return __builtin_bit_cast(bf16x4, w); }
__device__ __forceinline__ bf16x8 pack8(f32x4 a, f32x4 b) { u32x4 w; w.x = pk2(a[0], a[1]); w.y = pk2(a[2], a[3]); w.z = pk2(b[0], b[1]); w.w = pk2(b[2], b[3]); return __builtin_bit_cast(bf16x8, w); }
__device__ __forceinline__ bf16x8 cat8(u32x2 lo, u32x2 hi) { u32x4 w; w.x = lo.x; w.y = lo.y; w.z = hi.x; w.w = hi.y; return __builtin_bit_cast(bf16x8, w); }

struct Ptrs {
    const float *x, *meta, *rel_bias, *lb_logits, *attn_norm_w, *w_in, *att_sinks, *ssd_conv_w, *ssd_conv_b, *ssd_dt_bias, *ssd_a_log, *ssd_d, *ssd_norm_w,
        *hg_norm_w, *w_branch, *w_out, *ffn_norm_w, *w_up, *ffn_conv_w, *ffn_conv_b, *w_down, *final_norm_w;
    float* out; unsigned char* ws;
};

__device__ __forceinline__ int win_srccol(int r0) {
    return r0 < 1024 ? r0 : r0 < 2048 ? 1280 + (r0 - 1024) : r0 < 3072 ? 7440 + (r0 - 2048) : r0 < 3200 ? 1024 + (r0 - 3072) : r0 < 3328 ? 1152 + (r0 - 3200)
         : r0 < 5376 ? 2304 + (r0 - 3328) : r0 < 6400 ? 4368 + (r0 - 5376) : r0 < 7424 ? 5392 + (r0 - 6400) : 6416 + (r0 - 7424);
}
__device__ __forceinline__ void convert_weights(const Ptrs& P, int l, unsigned char* lds, int gw, int NGW, int lane, int wave) {
    float* scr = (float*)(lds + wave * 16384);
    unsigned char* dob = (unsigned char*)P.out;
    const float* win = P.w_in + (size_t)l * DM * DIN;
#define CONV_DECODE(it) \
            const float* W; bf16_t* WT; int ld, col, K, kb; \
            if (it < 8448) { kb = it & 31; const int r0 = 32 * (it >> 5); W = win; ld = DIN; col = win_srccol(r0); K = DM; WT = (bf16_t*)(dob + DO_WIN) + (size_t)r0 * DM; } \
            else if (it < 14592) { const int i2 = it - 8448; kb = i2 & 31; const int r0 = 32 * (i2 >> 5); W = win; ld = DIN; col = 8464 + r0; K = DM; WT = (bf16_t*)(dob + DO_WG) + (size_t)r0 * DM; } \
            else if (it < 17664) { const int i2 = it - 14592, n = i2 >> 10, i3 = i2 & 1023; kb = i3 & 15; const int r0 = 32 * (i3 >> 4); W = P.w_branch + ((size_t)l * 3 + n) * 1024 * DM; ld = DM; col = r0; K = 1024; \
                WT = (bf16_t*)(dob + DO_WB) + (size_t)n * DM * 1024 + (size_t)r0 * 1024; } \
            else if (it < 19712) { const int i2 = it - 17664; kb = i2 & 31; const int r0 = 32 * (i2 >> 5); W = P.w_out + (size_t)l * DM * DM; ld = DM; col = r0; K = DM; WT = (bf16_t*)(dob + DO_WO) + (size_t)r0 * DM; } \
            else if (it < 30976) { const int i2 = it - 19712; kb = i2 & 31; const int r0 = 32 * (i2 >> 5); W = P.w_up + (size_t)l * DM * 2 * DFF; ld = 2 * DFF; col = r0; K = DM; WT = (bf16_t*)(dob + DO_WUP) + (size_t)r0 * DM; } \
            else { const int i2 = it - 30976; kb = i2 % 88; const int r0 = 32 * (i2 / 88); W = P.w_down + (size_t)l * DFF * DM; ld = DM; col = r0; K = DFF; WT = (bf16_t*)(dob + DO_WD) + (size_t)r0 * DFF; } \
        const int k0 = 64 * kb;
#define CONV_LOAD(dst) do { _Pragma("unroll") for (int i = 0; i < 32; ++i) { const int kk = 2 * i + (lane >> 5); dst[i] = W[(size_t)(k0 + kk) * ld + col + (lane & 31)]; } } while (0)
    float wn_[32];
    if (gw < 36608) { const int it = gw; CONV_DECODE(it) CONV_LOAD(wn_); }
    for (int it = gw; it < 36608; it += NGW) {
        bf16_t* WTc; int Kc, k0c;
        { CONV_DECODE(it) WTc = WT; Kc = K; k0c = k0; (void)W; (void)ld; (void)col; }
        float wv_[32];
#pragma unroll
        for (int i = 0; i < 32; ++i) wv_[i] = wn_[i];
        if (it + NGW < 36608) { const int it2 = it + NGW; CONV_DECODE(it2) CONV_LOAD(wn_); }
#pragma unroll
        for (int i = 0; i < 32; ++i) { const int kk = 2 * i + (lane >> 5); scr[kk * 33 + (lane & 31)] = wv_[i]; }
        asm volatile("s_waitcnt lgkmcnt(0)" ::: "memory");
        const int cc = lane & 7;
#pragma unroll
        for (int j = 0; j < 4; ++j) { const int n = (lane >> 3) + 8 * j; const float* s = scr + (8 * cc) * 33 + n;
            u32x4 o; o.x = pk2(s[0 * 33], s[1 * 33]); o.y = pk2(s[2 * 33], s[3 * 33]); o.z = pk2(s[4 * 33], s[5 * 33]); o.w = pk2(s[6 * 33], s[7 * 33]);
            *(u32x4*)(WTc + (size_t)n * Kc + k0c + 8 * cc) = o; }
        asm volatile("s_waitcnt lgkmcnt(0)" ::: "memory");
    }
#undef CONV_DECODE
#undef CONV_LOAD
    bf16_t* WdtT = (bf16_t*)(dob + DO_WDT);
    for (int idx = gw * 64 + lane; idx < 16 * DM; idx += NGW * 64) { const int j = idx >> 11, k = idx & 2047; WdtT[idx] = (bf16_t)f2bf(win[(size_t)k * DIN + 4352 + j]); }
}

template <int MODE> __device__ __forceinline__ void norm_phase(const Ptrs& P, const float* nw, int gw, int NGW, int lane) {
    bf16_t* H = (bf16_t*)(P.ws + WS_H); bf16_t* U = (bf16_t*)(P.ws + WS_U);
    const int nrows = (MODE == 2) ? MMAIN : MTOK;
    f32x4 xn[8]; u32x2 hn[8];
#define NORM_LOAD(r_) do { const int rr_ = (r_); if (MODE == 1) { const float* src = (rr_ < MMAIN) ? (P.x + (size_t)rr_ * DM) : (P.meta + (size_t)((rr_ - MMAIN) & 15) * DM); \
        _Pragma("unroll") for (int j = 0; j < 8; ++j) xn[j] = ((const f32x4*)src)[64 * j + lane]; } \
      else { _Pragma("unroll") for (int j = 0; j < 8; ++j) hn[j] = ((const u32x2*)(H + (size_t)rr_ * DM))[64 * j + lane]; } } while (0)
    int row = gw;
    if (row < nrows) NORM_LOAD(row);
    for (; row < nrows; row += NGW) {
        f32x4 v[8]; float ss = 0.f;
#pragma unroll
        for (int j = 0; j < 8; ++j) v[j] = (MODE == 1) ? xn[j] : (f32x4){bflo(hn[j].x), bfhi(hn[j].x), bflo(hn[j].y), bfhi(hn[j].y)};
        if (row + NGW < nrows) NORM_LOAD(row + NGW);
#pragma unroll
        for (int j = 0; j < 8; ++j) ss += (v[j][0] * v[j][0] + v[j][1] * v[j][1]) + (v[j][2] * v[j][2] + v[j][3] * v[j][3]);
        ss = wave_sum(ss, lane);
        const float rstd = 1.0f / sqrtf(ss * (1.0f / DM) + EPS);
        if (MODE == 1) {
#pragma unroll
            for (int j = 0; j < 8; ++j) { u32x2 w; w.x = pk2(v[j][0], v[j][1]); w.y = pk2(v[j][2], v[j][3]); ((u32x2*)(H + (size_t)row * DM))[64 * j + lane] = w; }
        }
#pragma unroll
        for (int j = 0; j < 8; ++j) {
            const f32x4 w4 = ((const f32x4*)nw)[64 * j + lane];
            const f32x4 o = v[j] * rstd * w4;
            if (MODE == 2) ((f32x4*)(P.out + (size_t)row * DM))[64 * j + lane] = o;
            else { u32x2 w; w.x = pk2(o[0], o[1]); w.y = pk2(o[2], o[3]); ((u32x2*)(U + (size_t)row * DM))[64 * j + lane] = w; }
        }
    }
#undef NORM_LOAD
}

__device__ __forceinline__ void dt_phase(const Ptrs& P, int gw, int NGW, int lane) {
    const bf16_t* U = (const bf16_t*)(P.ws + WS_U); const bf16_t* WdtT = (const bf16_t*)((unsigned char*)P.out + DO_WDT); float* dtraw = (float*)((unsigned char*)P.out + DO_DTRAW);
    const int lc = lane & 15, g = lane >> 4;
    for (int it = gw; it < MTOK / 16; it += NGW) {
        const int r0 = 16 * it; f32x4 acc = {0.f, 0.f, 0.f, 0.f};
        const bf16_t* ap = U + (size_t)(r0 + lc) * DM + 8 * g; const bf16_t* bp = WdtT + (size_t)lc * DM + 8 * g;
#pragma unroll 8
        for (int ks = 0; ks < 64; ++ks) { const bf16x8 a = *(const bf16x8*)(ap + ks * 32); const bf16x8 b = *(const bf16x8*)(bp + ks * 32); acc = mfma32(a, b, acc); }
#pragma unroll
        for (int r = 0; r < 4; ++r) dtraw[(size_t)(r0 + 4 * g + r) * 16 + lc] = acc[r];
    }
}

constexpr int AT_KS = 0, AT_VT = 36864, AT_KM = 72704, AT_HB = 75008, AT_BKT = 159744, AT_RB = 160256;
__device__ __forceinline__ void attn_tables(const Ptrs& P, unsigned char* lds, int tid) {
    int* bkt = (int*)(lds + AT_BKT); float* rb = (float*)(lds + AT_RB);
    if (tid < 128) { int bk; if (tid < 16) bk = tid; else { const float nf = (float)tid; int lg = 16 + (int)(logf(nf / 16.0f) / 2.0794415416798357f * 16.0f); bk = lg < 31 ? lg : 31; } bkt[tid] = bk; }
    rb[tid] = P.rel_bias[tid];
}
__device__ __forceinline__ void attn_unit(const Ptrs& P, int l, int b, int gk, int n, unsigned char* lds, int tid, bool dost) {
    bf16_t* PJ = (bf16_t*)(P.ws + WS_R);
    const int lane = tid & 63, w = tid >> 6, lc = lane & 15, g = lane >> 4;
    bf16_t* Vt = (bf16_t*)(lds + AT_VT); const int* bkt = (const int*)(lds + AT_BKT); const float* rb = (const float*)(lds + AT_RB); float* hb = (float*)(lds + AT_HB);
    {
        const int key = tid >> 1, half = tid & 1; const bool valid = (n >= 2) || (n == 1 && key >= 128);
        u32x4 kv[4], vv[4];
        if (valid) { const bf16_t* rp = PJ + (size_t)(b * SEQ + (n - 2) * 128 + key) * PW + gk * 64 + half * 32;
#pragma unroll
            for (int i = 0; i < 4; ++i) { kv[i] = *(const u32x4*)(rp + C_AK + 8 * i); vv[i] = *(const u32x4*)(rp + C_AV + 8 * i); } }
        else {
#pragma unroll
            for (int i = 0; i < 4; ++i) { kv[i] = (u32x4){0u, 0u, 0u, 0u}; vv[i] = (u32x4){0u, 0u, 0u, 0u}; } }
#pragma unroll
        for (int i = 0; i < 4; ++i) {
            *(u32x4*)(lds + AT_KS + key * 144 + half * 64 + i * 16) = kv[i];
            const int d0 = half * 32 + i * 8;
            Vt[(d0 + 0) * 280 + key] = (bf16_t)(vv[i].x & 0xffffu); Vt[(d0 + 1) * 280 + key] = (bf16_t)(vv[i].x >> 16);
            Vt[(d0 + 2) * 280 + key] = (bf16_t)(vv[i].y & 0xffffu); Vt[(d0 + 3) * 280 + key] = (bf16_t)(vv[i].y >> 16);
            Vt[(d0 + 4) * 280 + key] = (bf16_t)(vv[i].z & 0xffffu); Vt[(d0 + 5) * 280 + key] = (bf16_t)(vv[i].z >> 16);
            Vt[(d0 + 6) * 280 + key] = (bf16_t)(vv[i].w & 0xffffu); Vt[(d0 + 7) * 280 + key] = (bf16_t)(vv[i].w >> 16);
        }
    }
    if (tid < 32) {
        const int m = tid >> 1, half = tid & 1; const bf16_t* rp = PJ + (size_t)(MMAIN + b * NMETA + m) * PW + gk * 64 + half * 32;
#pragma unroll
        for (int i = 0; i < 4; ++i) { const u32x4 kvv = *(const u32x4*)(rp + C_AK + 8 * i); const u32x4 vvv = *(const u32x4*)(rp + C_AV + 8 * i);
            *(u32x4*)(lds + AT_KM + m * 144 + half * 64 + i * 16) = kvv;
            const int d0 = half * 32 + i * 8;
            Vt[(d0 + 0) * 280 + 256 + m] = (bf16_t)(vvv.x & 0xffffu); Vt[(d0 + 1) * 280 + 256 + m] = (bf16_t)(vvv.x >> 16);
            Vt[(d0 + 2) * 280 + 256 + m] = (bf16_t)(vvv.y & 0xffffu); Vt[(d0 + 3) * 280 + 256 + m] = (bf16_t)(vvv.y >> 16);
            Vt[(d0 + 4) * 280 + 256 + m] = (bf16_t)(vvv.z & 0xffffu); Vt[(d0 + 5) * 280 + 256 + m] = (bf16_t)(vvv.z >> 16);
            Vt[(d0 + 6) * 280 + 256 + m] = (bf16_t)(vvv.w & 0xffffu); Vt[(d0 + 7) * 280 + 256 + m] = (bf16_t)(vvv.w >> 16); }
    }
    const int head = gk * 8 + w;
    hb[w * 128 + lane] = rb[bkt[lane] * 16 + head]; hb[w * 128 + 64 + lane] = rb[bkt[64 + lane] * 16 + head];
    __syncthreads();
    const float sink = P.att_sinks[l * 16 + head];
    const int qs0 = (n == 0) ? 7 : 0;
    bf16x8 qn0, qn1;
    { const bf16_t* qp = PJ + (size_t)tok_row(b, n * 128 + 16 * qs0 + lc - 112) * PW + C_AQ + head * 64; qn0 = *(const bf16x8*)(qp + 8 * g); qn1 = *(const bf16x8*)(qp + 32 + 8 * g); }
#pragma unroll 1
    for (int qs = qs0; qs < 8; ++qs) {
        const int tq = n * 128 + 16 * qs + lc - 112;
        const size_t qrow = (size_t)tok_row(b, tq);
        bf16_t* qp = PJ + qrow * PW + C_AQ + head * 64;
        const bf16x8 q0 = qn0, q1 = qn1;
        if (qs + 1 < 8) { const bf16_t* qp2 = PJ + (size_t)tok_row(b, tq + 16) * PW + C_AQ + head * 64; qn0 = *(const bf16x8*)(qp2 + 8 * g); qn1 = *(const bf16x8*)(qp2 + 32 + 8 * g); }
        f32x4 st[10];
#pragma unroll
        for (int kt = 0; kt < 9; ++kt) { const unsigned char* kp = lds + AT_KS + (16 * (qs + kt) + lc) * 144 + 16 * g;
            const bf16x8 a0 = *(const bf16x8*)kp, a1 = *(const bf16x8*)(kp + 64);
            f32x4 z = {0.f, 0.f, 0.f, 0.f}; z = mfma32(a0, q0, z); st[kt] = mfma32(a1, q1, z); }
        { const unsigned char* kp = lds + AT_KM + lc * 144 + 16 * g; const bf16x8 a0 = *(const bf16x8*)kp, a1 = *(const bf16x8*)(kp + 64);
            f32x4 z = {0.f, 0.f, 0.f, 0.f}; z = mfma32(a0, q0, z); st[9] = mfma32(a1, q1, z); }
        float mx = sink;
#pragma unroll
        for (int kt = 0; kt < 9; ++kt)
#pragma unroll
            for (int r = 0; r < 4; ++r) { const int dist = 128 + lc - 16 * kt - 4 * g - r; const int j = 16 * (qs + kt) + 4 * g + r;
                const bool valid = (dist >= 0) && (dist < 128) && (n >= 1) && (n >= 2 || j >= 128);
                const float lg = valid ? (st[kt][r] * 0.125f + hb[w * 128 + (dist & 127)]) : NEGV; st[kt][r] = lg; mx = fmaxf(mx, lg); }
#pragma unroll
        for (int r = 0; r < 4; ++r) { const int dist = tq - (4 * g + r); const bool valid = dist >= 0; const int bk = (dist >= 0 && dist < 128) ? bkt[dist & 127] : 31;
            const float lg = valid ? (st[9][r] * 0.125f + rb[bk * 16 + head]) : NEGV; st[9][r] = lg; mx = fmaxf(mx, lg); }
        mx = fmaxf(mx, shx(mx, 16, lane)); mx = fmaxf(mx, shx(mx, 32, lane));
        float sum = 0.f;
#pragma unroll
        for (int kt = 0; kt < 10; ++kt)
#pragma unroll
            for (int r = 0; r < 4; ++r) { const float p = __expf(st[kt][r] - mx); st[kt][r] = p; sum += p; }
        sum += shx(sum, 16, lane); sum += shx(sum, 32, lane);
        const float inv = 1.0f / (sum + __expf(sink - mx));
        f32x4 o[4];
#pragma unroll
        for (int dt = 0; dt < 4; ++dt) o[dt] = (f32x4){0.f, 0.f, 0.f, 0.f};
#pragma unroll
        for (int j = 0; j < 5; ++j) {
            const bf16x8 pb = pack8(st[2 * j], st[2 * j + 1]);
            const int colA = 16 * (qs + 2 * j) + 4 * g; const int colB = (j < 4) ? (16 * (qs + 2 * j + 1) + 4 * g) : (256 + 4 * g);
#pragma unroll
            for (int dt = 0; dt < 4; ++dt) { const int d = 16 * dt + lc;
                const u32x2 lo = *(const u32x2*)(Vt + d * 280 + colA), hi = *(const u32x2*)(Vt + d * 280 + colB);
                o[dt] = mfma32(cat8(lo, hi), pb, o[dt]); }
        }
#pragma unroll
        for (int dt = 0; dt < 4; ++dt) { u32x2 wv; wv.x = pk2(o[dt][0] * inv, o[dt][1] * inv); wv.y = pk2(o[dt][2] * inv, o[dt][3] * inv); if (dost) *(u32x2*)(qp + 16 * dt + 4 * g) = wv; }
    }
    __syncthreads();
}

constexpr int SD_XT = 0, SD_BS = 69632, SD_CS = 104448, SD_ACS = 139264, SD_DTS = 141312, SD_SSQ = 143360, SD_WS = 145408;
__device__ __forceinline__ int sdz(int row, int col) { return row * 136 + (col ^ (((row >> 3) & 15) << 3)); }
template <bool PASSA> __device__ __forceinline__ void ssd_stage(const Ptrs& P, int l, int b, int ch, int gg, unsigned char* lds, int tid) {
    const bf16_t* PJ = (const bf16_t*)(P.ws + WS_R);
    const int lane = tid & 63, seg = tid >> 6, l0 = 16 * seg, nvalid = (ch == 0) ? 16 : 128;
    bf16_t* Xt = (bf16_t*)(lds + SD_XT); bf16_t* Bs = (bf16_t*)(lds + SD_BS); bf16_t* Cs = (bf16_t*)(lds + SD_CS);
    int kind, xcol, i0;
    if (lane < 32) { kind = 0; i0 = 8 * lane; xcol = gg * 256 + i0; }
    else if (lane < 48) { kind = 1; i0 = 8 * (lane - 32); xcol = 1024 + gg * 128 + i0; }
    else { kind = 2; i0 = 8 * (lane - 48); xcol = 1536 + gg * 128 + i0; }
    if (!(PASSA && kind == 2)) {
        float wgt[4][8], bias[8];
        const float* cw = P.ssd_conv_w + (size_t)l * 4 * 2048 + xcol; const float* cb = P.ssd_conv_b + (size_t)l * 2048 + xcol;
#pragma unroll
        for (int k = 0; k < 4; ++k) { const f32x4 a = *(const f32x4*)(cw + k * 2048), c2 = *(const f32x4*)(cw + k * 2048 + 4);
            wgt[k][0] = a[0]; wgt[k][1] = a[1]; wgt[k][2] = a[2]; wgt[k][3] = a[3]; wgt[k][4] = c2[0]; wgt[k][5] = c2[1]; wgt[k][6] = c2[2]; wgt[k][7] = c2[3]; }
        { const f32x4 a = *(const f32x4*)cb, c2 = *(const f32x4*)(cb + 4); bias[0] = a[0]; bias[1] = a[1]; bias[2] = a[2]; bias[3] = a[3]; bias[4] = c2[0]; bias[5] = c2[1]; bias[6] = c2[2]; bias[7] = c2[3]; }
        const int t0 = (ch == 0) ? l0 : (NMETA + 128 * (ch - 1) + l0);
        float x0[8], x1[8], x2[8], x3[8];
        const bool live = l0 < nvalid;
#define SSD_LDX(dst, tt) do { const int t_ = (tt); if (live && t_ >= 0) { const u32x4 w_ = *(const u32x4*)(PJ + (size_t)tok_row(b, t_) * PW + C_XBC + xcol); unpack8(w_, dst); } \
            else { _Pragma("unroll") for (int e_ = 0; e_ < 8; ++e_) dst[e_] = 0.f; } } while (0)
#define SSD_LD(tt) ((live && (tt) >= 0) ? *(const u32x4*)(PJ + (size_t)tok_row(b, (tt)) * PW + C_XBC + xcol) : (u32x4){0u, 0u, 0u, 0u})
        { const u32x4 h0 = SSD_LD(t0 - 3), h1 = SSD_LD(t0 - 2), h2 = SSD_LD(t0 - 1); unpack8(h0, x0); unpack8(h1, x1); unpack8(h2, x2); }
        u32x4 n0 = SSD_LD(t0), n1 = SSD_LD(t0 + 1), n2 = SSD_LD(t0 + 2), n3 = SSD_LD(t0 + 3);
#pragma unroll 1
        for (int i = 0; i < 16; ++i) {
            const int li = l0 + i;
            unpack8(n0, x3); n0 = n1; n1 = n2; n2 = n3; n3 = (i + 4 < 16) ? SSD_LD(t0 + i + 4) : (u32x4){0u, 0u, 0u, 0u};
            float o[8];
#pragma unroll
            for (int e = 0; e < 8; ++e) { float v = bias[e] + wgt[0][e] * x0[e] + wgt[1][e] * x1[e] + wgt[2][e] * x2[e] + wgt[3][e] * x3[e]; v = siluf(v); o[e] = (li < nvalid) ? v : 0.f;
                x0[e] = x1[e]; x1[e] = x2[e]; x2[e] = x3[e]; }
            if (kind == 0) {
#pragma unroll
                for (int e = 0; e < 8; ++e) Xt[sdz(i0 + e, li)] = (bf16_t)f2bf(o[e]);
            } else if (kind == 1) {
                if (PASSA) {
#pragma unroll
                    for (int e = 0; e < 8; ++e) Bs[sdz(i0 + e, li)] = (bf16_t)f2bf(o[e]);
                } else { u32x4 wv; wv.x = pk2(o[0], o[1]); wv.y = pk2(o[2], o[3]); wv.z = pk2(o[4], o[5]); wv.w = pk2(o[6], o[7]); *(u32x4*)(Bs + li * 136 + i0) = wv; }
            } else { u32x4 wv; wv.x = pk2(o[0], o[1]); wv.y = pk2(o[2], o[3]); wv.z = pk2(o[4], o[5]); wv.w = pk2(o[6], o[7]); *(u32x4*)(Cs + li * 136 + i0) = wv; }
        }
#undef SSD_LD
#undef SSD_LDX
    }
    float* ACS = (float*)(lds + SD_ACS); float* DTS = (float*)(lds + SD_DTS);
    { const int hh = tid >> 7, li = tid & 127; const int h = gg * 4 + hh; float dt = 0.f, dA = 0.f;
      if (li < nvalid) { const int row = (ch == 0) ? (MMAIN + b * NMETA + li) : (b * SEQ + 128 * (ch - 1) + li);
          const float* dtraw = (const float*)((const unsigned char*)P.out + DO_DTRAW);
          const float raw = dtraw[(size_t)row * 16 + h] + P.ssd_dt_bias[l * 16 + h];
          dt = raw > 20.f ? raw : log1pf(__expf(raw)); dA = -dt * __expf(P.ssd_a_log[l * 16 + h]); }
      DTS[hh * 128 + li] = dt; ACS[hh * 128 + li] = dA; }
    __syncthreads();
    if (seg < 4) { const int hh = seg; const float v0 = ACS[hh * 128 + 2 * lane], v1 = ACS[hh * 128 + 2 * lane + 1]; const float s = v0 + v1; float sc = s;
#pragma unroll
        for (int o = 1; o < 64; o <<= 1) { const float t = __builtin_bit_cast(float, __builtin_amdgcn_ds_bpermute(((lane - o) & 63) << 2, __builtin_bit_cast(int, sc))); if (lane >= o) sc += t; }
        const float ex = sc - s; ACS[hh * 128 + 2 * lane] = ex + v0; ACS[hh * 128 + 2 * lane + 1] = ex + v0 + v1; }
    __syncthreads();
}

__device__ __forceinline__ void ssd_passA(const Ptrs& P, int l, int b, int ch, int gg, unsigned char* lds, int tid) {
    ssd_stage<true>(P, l, b, ch, gg, lds, tid);
    const int lane = tid & 63, w = tid >> 6, lc = lane & 15, g = lane >> 4, hh = w & 3, half = w >> 2, h = gg * 4 + hh;
    const float* ACS = (const float*)(lds + SD_ACS); const float* DTS = (const float*)(lds + SD_DTS); float* WSg = (float*)(lds + SD_WS);
    const bf16_t* Xt = (const bf16_t*)(lds + SD_XT); const bf16_t* Bt = (const bf16_t*)(lds + SD_BS);
    { const int h2 = tid >> 7, s = tid & 127; WSg[h2 * 128 + s] = __expf(ACS[h2 * 128 + 127] - ACS[h2 * 128 + s]) * DTS[h2 * 128 + s]; }
    __syncthreads();
    bf16x8 af[4][4];
#pragma unroll
    for (int pt = 0; pt < 4; ++pt)
#pragma unroll
        for (int ks = 0; ks < 4; ++ks) { const u32x4 raw = *(const u32x4*)(Xt + sdz(hh * 64 + 16 * pt + lc, 32 * ks + 8 * g)); float f[8]; unpack8(raw, f);
            const float* wp = WSg + hh * 128 + 32 * ks + 8 * g;
            u32x4 o; o.x = pk2(f[0] * wp[0], f[1] * wp[1]); o.y = pk2(f[2] * wp[2], f[3] * wp[3]); o.z = pk2(f[4] * wp[4], f[5] * wp[5]); o.w = pk2(f[6] * wp[6], f[7] * wp[7]);
            af[pt][ks] = __builtin_bit_cast(bf16x8, o); }
    bf16_t* ST = (bf16_t*)(P.ws + WS_X) + (size_t)((b * NCH + ch) * 16 + h) * 8192;
#pragma unroll 1
    for (int nt = 4 * half; nt < 4 * half + 4; ++nt) {
        f32x4 st[4];
#pragma unroll
        for (int pt = 0; pt < 4; ++pt) st[pt] = (f32x4){0.f, 0.f, 0.f, 0.f};
#pragma unroll
        for (int ks = 0; ks < 4; ++ks) { const bf16x8 bfr = *(const bf16x8*)(Bt + sdz(16 * nt + lc, 32 * ks + 8 * g));
#pragma unroll
            for (int pt = 0; pt < 4; ++pt) st[pt] = mfma32(af[pt][ks], bfr, st[pt]); }
#pragma unroll
        for (int pt = 0; pt < 4; ++pt)
#pragma unroll
            for (int r = 0; r < 4; ++r) ST[(16 * pt + 4 * g + r) * 128 + 16 * nt + lc] = (bf16_t)f2bf(st[pt][r]);
    }
    if (tid < 4) { float* dec = (float*)((unsigned char*)P.out + DO_SSDDEC); dec[(b * NCH + ch) * 16 + gg * 4 + tid] = __expf(ACS[tid * 128 + 127]); }
    __syncthreads();
}

__device__ __forceinline__ void ssd_passB(const Ptrs& P, int l, int b, int ch, int gg, unsigned char* lds, int tid, bool dost) {
    ssd_stage<false>(P, l, b, ch, gg, lds, tid);
    bf16_t* PJ = (bf16_t*)(P.ws + WS_R);
    const int lane = tid & 63, w = tid >> 6, lc = lane & 15, g = lane >> 4, hh = w & 3, half = w >> 2, h = gg * 4 + hh;
    const float* ACS = (const float*)(lds + SD_ACS) + hh * 128; const float* DTS = (const float*)(lds + SD_DTS) + hh * 128; float* SSQ = (float*)(lds + SD_SSQ);
    const bf16_t* Xt = (const bf16_t*)(lds + SD_XT); const bf16_t* Bs = (const bf16_t*)(lds + SD_BS); const bf16_t* Cs = (const bf16_t*)(lds + SD_CS);
    const bf16_t* ST = (const bf16_t*)(P.ws + WS_X) + (size_t)((b * NCH + ch) * 16 + h) * 8192;
    const int nlt = (ch == 0) ? (half == 0 ? 1 : 0) : 4;
    const float dsk = P.ssd_d[l * 16 + h];
    bf16x8 sf[4][4];
#pragma unroll
    for (int pt = 0; pt < 4; ++pt)
#pragma unroll
        for (int ks = 0; ks < 4; ++ks) sf[pt][ks] = *(const bf16x8*)(ST + (16 * pt + lc) * 128 + 32 * ks + 8 * g);
    u32x2 zwv[4][4];
#pragma unroll
    for (int lti = 0; lti < 4; ++lti) {
        const int lt = (lti == 0) ? half : (lti == 1) ? 3 - half : (lti == 2) ? 4 + half : 7 - half, li = 16 * lt + lc;
        const bool rv = (lti < nlt) && ((ch != 0) || (li < 16));
        const size_t row = (ch == 0) ? (size_t)(MMAIN + b * NMETA + (li & 15)) : (size_t)(b * SEQ + 128 * (ch - 1) + li);
#pragma unroll
        for (int pt = 0; pt < 4; ++pt) { zwv[lti][pt] = (u32x2){0u, 0u}; if (rv) zwv[lti][pt] = *(const u32x2*)(PJ + row * PW + C_SZ + h * 64 + 16 * pt + 4 * g); } }
    f32x4 gz[4][4];
#pragma unroll
    for (int lti = 0; lti < 4; ++lti) {
#pragma unroll
        for (int pt = 0; pt < 4; ++pt) gz[lti][pt] = (f32x4){0.f, 0.f, 0.f, 0.f};
        if (lti < nlt) {
            const int lt = (lti == 0) ? half : (lti == 1) ? 3 - half : (lti == 2) ? 4 + half : 7 - half, li = 16 * lt + lc; const float Al = ACS[li];
            bf16x8 cf[4];
#pragma unroll
            for (int ks = 0; ks < 4; ++ks) cf[ks] = *(const bf16x8*)(Cs + li * 136 + 32 * ks + 8 * g);
            f32x4 o[4];
#pragma unroll
            for (int pt = 0; pt < 4; ++pt) { f32x4 z = {0.f, 0.f, 0.f, 0.f};
#pragma unroll
                for (int ks = 0; ks < 4; ++ks) z = mfma32(sf[pt][ks], cf[ks], z);
                const float eA = __expf(Al); o[pt] = z * eA; }
            for (int j = 0; j <= (lt >> 1); ++j) {
                f32x4 cb0 = {0.f, 0.f, 0.f, 0.f}, cb1 = {0.f, 0.f, 0.f, 0.f};
#pragma unroll
                for (int ks = 0; ks < 4; ++ks) { const bf16x8 a0 = *(const bf16x8*)(Bs + (32 * j + lc) * 136 + 32 * ks + 8 * g), a1 = *(const bf16x8*)(Bs + (32 * j + 16 + lc) * 136 + 32 * ks + 8 * g);
                    cb0 = mfma32(a0, cf[ks], cb0); cb1 = mfma32(a1, cf[ks], cb1); }
#pragma unroll
                for (int r = 0; r < 4; ++r) { const int s0 = 32 * j + 4 * g + r, s1 = s0 + 16;
                    cb0[r] = (s0 <= li) ? cb0[r] * __expf(Al - ACS[s0]) * DTS[s0] : 0.f;
                    cb1[r] = (s1 <= li) ? cb1[r] * __expf(Al - ACS[s1]) * DTS[s1] : 0.f; }
                const bf16x8 pb = pack8(cb0, cb1);
#pragma unroll
                for (int pt = 0; pt < 4; ++pt) { const int xr = hh * 64 + 16 * pt + lc;
                    const u32x2 lo = *(const u32x2*)(Xt + sdz(xr, 32 * j + 4 * g)), hi = *(const u32x2*)(Xt + sdz(xr, 32 * j + 16 + 4 * g)); o[pt] = mfma32(cat8(lo, hi), pb, o[pt]); }
            }
            const bool rv = (ch != 0) || (li < 16);
            const size_t row = (ch == 0) ? (size_t)(MMAIN + b * NMETA + (li & 15)) : (size_t)(b * SEQ + 128 * (ch - 1) + li);
            float part = 0.f;
#pragma unroll
            for (int pt = 0; pt < 4; ++pt) { const u32x2 zw = zwv[lti][pt];
                const float zf[4] = {bflo(zw.x), bfhi(zw.x), bflo(zw.y), bfhi(zw.y)};
#pragma unroll
                for (int r = 0; r < 4; ++r) { const float xs = bf2f(Xt[sdz(hh * 64 + 16 * pt + 4 * g + r, li)]); const float y = o[pt][r] + xs * dsk; const float v = y * siluf(zf[r]); gz[lti][pt][r] = v; part += v * v; } }
            part += shx(part, 16, lane); part += shx(part, 32, lane);
            if (g == 0) SSQ[li * 4 + hh] = part;
        }
    }
    f32x4 nwv[4];
#pragma unroll
    for (int pt = 0; pt < 4; ++pt) nwv[pt] = *(const f32x4*)(P.ssd_norm_w + l * 1024 + h * 64 + 16 * pt + 4 * g);
    __syncthreads();
#pragma unroll
    for (int lti = 0; lti < 4; ++lti) {
        if (lti < nlt) {
            const int lt = (lti == 0) ? half : (lti == 1) ? 3 - half : (lti == 2) ? 4 + half : 7 - half, li = 16 * lt + lc;
            const bool rv = (ch != 0) || (li < 16);
            const size_t row = (ch == 0) ? (size_t)(MMAIN + b * NMETA + (li & 15)) : (size_t)(b * SEQ + 128 * (ch - 1) + li);
            const float tot = (SSQ[li * 4 + 0] + SSQ[li * 4 + 1]) + (SSQ[li * 4 + 2] + SSQ[li * 4 + 3]);
            const float rstd = 1.0f / sqrtf(tot * (1.0f / 256.0f) + EPS);
            if (rv && dost) {
#pragma unroll
                for (int pt = 0; pt < 4; ++pt) { const f32x4 nw = nwv[pt];
                    u32x2 wv; wv.x = pk2(gz[lti][pt][0] * rstd * nw[0], gz[lti][pt][1] * rstd * nw[1]); wv.y = pk2(gz[lti][pt][2] * rstd * nw[2], gz[lti][pt][3] * rstd * nw[3]);
                    *(u32x2*)(PJ + row * PW + C_SZ + h * 64 + 16 * pt + 4 * g) = wv; }
            }
        }
    }
    __syncthreads();
}

constexpr int HG_QB = 0, HG_KB = 34816, HG_KET = 69632, HG_EBE = 110592, HG_VT = 114688, HG_SSQ = 155648;
__device__ __forceinline__ void hg_unit(const Ptrs& P, int l, int b, int hd, int ch, unsigned char* lds, int tid) {
    bf16_t* PJ = (bf16_t*)(P.ws + WS_R);
    const int lane = tid & 63, w = tid >> 6, lc = lane & 15, g = lane >> 4;
    const int nsub = (ch == 0) ? 1 : 8;
    const size_t row0 = (ch == 0) ? (size_t)(MMAIN + b * NMETA) : (size_t)(b * SEQ + 128 * (ch - 1));
    bf16_t* Qb = (bf16_t*)(lds + HG_QB); bf16_t* Kb = (bf16_t*)(lds + HG_KB); bf16_t* Ket = (bf16_t*)(lds + HG_KET); float* EBE = (float*)(lds + HG_EBE);
    bf16_t* Vt = (bf16_t*)(lds + HG_VT) + w * 8 * 16 * 20; float* DT = (float*)(lds + HG_SSQ);
    bf16_t* HS = (bf16_t*)((unsigned char*)P.out + DO_HGS) + (size_t)((b * 8 + hd) * NCH + ch) * 16384;
    u32x2 vv[8];
    { const int t = lane >> 2, v4 = (lane & 3) * 4;
#pragma unroll
      for (int j = 0; j < 8; ++j) { vv[j] = (u32x2){0u, 0u}; if (j < nsub) vv[j] = *(const u32x2*)(PJ + (row0 + 16 * j + t) * PW + C_HI + hd * 128 + 16 * w + v4); } }
    {
        const int dk = tid & 127, sg = tid >> 7;
        float lb = 0.f;
        if (l == 1) { const float a0 = P.lb_logits[hd * 128 + dk], a1 = P.lb_logits[1024 + hd * 128 + dk]; const float mxx = fmaxf(a0, a1); const float e0 = __expf(a0 - mxx), e1 = __expf(a1 - mxx);
            lb = e1 / (e0 + e1); lb = fminf(fmaxf(lb, 0.f), 1.0f - 1e-4f); }
        bf16_t hfv[2][16], hqv[2][16];
#pragma unroll
        for (int jj = 0; jj < 2; ++jj) { const int j = 2 * sg + jj;
#pragma unroll
            for (int t = 0; t < 16; ++t) { hfv[jj][t] = 0; hqv[jj][t] = 0;
                if (j < nsub) { const bf16_t* rp = PJ + (row0 + 16 * j + t) * PW + hd * 128 + dk; hfv[jj][t] = rp[C_HF]; hqv[jj][t] = rp[C_HQ]; } } }
#pragma unroll
        for (int jj = 0; jj < 2; ++jj) { const int j = 2 * sg + jj;
            if (j < nsub) {
                float kk[16]; float eb = 1.f;
#pragma unroll
                for (int t = 0; t < 16; ++t) {
                    const float ff = bf2f(hfv[jj][t]); const float qv = bf2f(hqv[jj][t]);
                    const float sg1 = sigm(ff); const float f = lb + (1.0f - lb) * sg1; eb *= f;
                    const float kv = (1.0f - lb) * (1.0f - sg1);
                    const float ebi = __builtin_amdgcn_rcpf(eb);
                    kk[t] = kv * ebi;
                    Qb[(16 * j + t) * 136 + dk] = (bf16_t)f2bf(siluf(qv) * eb);
                    Kb[(16 * j + t) * 136 + dk] = (bf16_t)f2bf(kk[t]); }
                const float ebe = eb;
#pragma unroll
                for (int t = 0; t < 16; t += 2) *(unsigned*)(Ket + (j * 128 + dk) * 20 + t) = pk2(kk[t] * ebe, kk[t + 1] * ebe);
                EBE[j * 128 + dk] = ebe;
            }
        }
    }
    { const int t = lane >> 2, v4 = (lane & 3) * 4;
#pragma unroll
      for (int j = 0; j < 8; ++j) { if (j < nsub) { bf16_t* vp = Vt + (j * 16 + v4) * 20 + t;
        vp[0] = (bf16_t)(vv[j].x & 0xffffu); vp[20] = (bf16_t)(vv[j].x >> 16); vp[40] = (bf16_t)(vv[j].y & 0xffffu); vp[60] = (bf16_t)(vv[j].y >> 16); } } }
    __syncthreads();
#define HG_ATT_SLOT(j_) (((lane >> 5) ? Kb : Qb) + (16 * (j_) + ((lane & 31) >> 1)) * 136 + 128 + 4 * (lane & 1))
    if (w < nsub) {
        f32x4 at = {0.f, 0.f, 0.f, 0.f};
#pragma unroll
        for (int ks = 0; ks < 4; ++ks) { const bf16x8 a = *(const bf16x8*)(Kb + (16 * w + lc) * 136 + 32 * ks + 8 * g), bq = *(const bf16x8*)(Qb + (16 * w + lc) * 136 + 32 * ks + 8 * g); at = mfma32(a, bq, at); }
#pragma unroll
        for (int r = 0; r < 4; ++r) at[r] = (4 * g + r <= lc) ? at[r] : 0.f;
        *(bf16x4*)HG_ATT_SLOT(w) = pack4(at);
    }
    if (tid < 128) { float d = 1.f;
        for (int j = 0; j < nsub; ++j) { DT[j * 128 + tid] = d; d *= EBE[j * 128 + tid]; }
        float* dec = (float*)((unsigned char*)P.out + DO_HGDEC); dec[(size_t)((b * 8 + hd) * NCH + ch) * 128 + tid] = d; }
    __syncthreads();
    {
        const int t = tid >> 2, sgm = tid & 3;
        if (t < 16 * nsub) { const int j = t >> 4; bf16_t* qo = PJ + (row0 + t) * PW + C_HQ + hd * 128 + 32 * sgm;
#pragma unroll
            for (int c8 = 0; c8 < 4; ++c8) { const u32x4 qw = *(const u32x4*)(Qb + t * 136 + 32 * sgm + 8 * c8); float f[8]; unpack8(qw, f);
                const f32x4 d0 = *(const f32x4*)(DT + j * 128 + 32 * sgm + 8 * c8), d1 = *(const f32x4*)(DT + j * 128 + 32 * sgm + 8 * c8 + 4);
                u32x4 o; o.x = pk2(f[0] * d0[0], f[1] * d0[1]); o.y = pk2(f[2] * d0[2], f[3] * d0[3]); o.z = pk2(f[4] * d1[0], f[5] * d1[1]); o.w = pk2(f[6] * d1[2], f[7] * d1[3]);
                *(u32x4*)(qo + 8 * c8) = o; } }
    }
    f32x4 S[8];
#pragma unroll
    for (int kt = 0; kt < 8; ++kt) S[kt] = (f32x4){0.f, 0.f, 0.f, 0.f};
#pragma unroll
    for (int j = 0; j < 8; ++j) {
        if (j < nsub) {
            const bf16x4 vf = *(const bf16x4*)(Vt + (j * 16 + lc) * 20 + 4 * g);
            const bf16x4 atj = *(const bf16x4*)HG_ATT_SLOT(j);
            f32x4 o = mfma16(vf, atj, (f32x4){0.f, 0.f, 0.f, 0.f});
            if (j > 0) {
#pragma unroll
                for (int kt = 0; kt < 8; ++kt) { const bf16x4 qf = *(const bf16x4*)(Qb + (16 * j + lc) * 136 + 16 * kt + 4 * g); o = mfma16(pack4(S[kt]), qf, o); } }
            { u32x2 wv; wv.x = pk2(o[0], o[1]); wv.y = pk2(o[2], o[3]); *(u32x2*)(PJ + (row0 + 16 * j + lc) * PW + C_HI + hd * 128 + 16 * w + 4 * g) = wv; }
#pragma unroll
            for (int kt = 0; kt < 8; ++kt) { const f32x4 eb = *(const f32x4*)(EBE + j * 128 + 16 * kt + 4 * g);
                const bf16x4 kf = *(const bf16x4*)(Ket + (j * 128 + 16 * kt + lc) * 20 + 4 * g);
                S[kt] = mfma16(kf, vf, S[kt] * eb); }
        }
    }
#pragma unroll
    for (int kt = 0; kt < 8; ++kt) { u32x2 wv; wv.x = pk2(S[kt][0], S[kt][1]); wv.y = pk2(S[kt][2], S[kt][3]); *(u32x2*)(HS + (16 * w + lc) * 128 + 16 * kt + 4 * g) = wv; }
    __syncthreads();
}

#undef HG_ATT_SLOT
__device__ __forceinline__ void hg_passB(const Ptrs& P, int l, int b, int hd, int ch, unsigned char* lds, int tid, bool dost) {
    bf16_t* PJ = (bf16_t*)(P.ws + WS_R);
    const int lane = tid & 63, w = tid >> 6, lc = lane & 15, g = lane >> 4;
    const int nsub = (ch == 0) ? 1 : 8;
    const size_t row0 = (ch == 0) ? (size_t)(MMAIN + b * NMETA) : (size_t)(b * SEQ + 128 * (ch - 1));
    float* SSQ = (float*)(lds + HG_SSQ);
    const bf16_t* HS = (const bf16_t*)((unsigned char*)P.out + DO_HGS) + (size_t)((b * 8 + hd) * NCH + ch) * 16384;
    bf16x8 sfr[4];
#pragma unroll
    for (int ks = 0; ks < 4; ++ks) sfr[ks] = *(const bf16x8*)(HS + (16 * w + lc) * 128 + 32 * ks + 8 * g);
    u32x2 ol[8], gv_[8];
#pragma unroll
    for (int j = 0; j < 8; ++j) { ol[j] = (u32x2){0u, 0u}; gv_[j] = ol[j];
        if (j < nsub) { const bf16_t* rp = PJ + (row0 + 16 * j + lc) * PW + hd * 128 + 16 * w + 4 * g; ol[j] = *(const u32x2*)(rp + C_HI); gv_[j] = *(const u32x2*)(rp + C_HG); } }
    bf16x8 qf[8][4];
#pragma unroll
    for (int j = 0; j < 8; ++j)
#pragma unroll
        for (int ks = 0; ks < 4; ++ks) { qf[j][ks] = (bf16x8){0, 0, 0, 0, 0, 0, 0, 0}; if (j < nsub) qf[j][ks] = *(const bf16x8*)(PJ + (row0 + 16 * j + lc) * PW + C_HQ + hd * 128 + 32 * ks + 8 * g); }
    f32x4 oo[8];
#pragma unroll
    for (int j = 0; j < 8; ++j) { f32x4 o = {bflo(ol[j].x), bfhi(ol[j].x), bflo(ol[j].y), bfhi(ol[j].y)};
#pragma unroll
        for (int ks = 0; ks < 4; ++ks) o = mfma32(sfr[ks], qf[j][ks], o);
        oo[j] = o; }
#pragma unroll
    for (int j = 0; j < 8; ++j) { float part = (oo[j][0] * oo[j][0] + oo[j][1] * oo[j][1]) + (oo[j][2] * oo[j][2] + oo[j][3] * oo[j][3]);
        part += shx(part, 16, lane); part += shx(part, 32, lane); if (g == 0) SSQ[w * 128 + 16 * j + lc] = part; }
    __syncthreads();
    const f32x4 nw = *(const f32x4*)(P.hg_norm_w + l * 128 + 16 * w + 4 * g);
#pragma unroll
    for (int j = 0; j < 8; ++j) {
        if (j < nsub) {
            float tot = 0.f;
#pragma unroll
            for (int ww = 0; ww < 8; ++ww) tot += SSQ[ww * 128 + 16 * j + lc];
            const float rstd = 1.0f / sqrtf(tot * (1.0f / 128.0f) + EPS);
            bf16_t* gp = PJ + (row0 + 16 * j + lc) * PW + C_HG + hd * 128 + 16 * w + 4 * g;
            const u32x2 gv = gv_[j];
            u32x2 wv; wv.x = pk2(oo[j][0] * rstd * nw[0] * siluf(bflo(gv.x)), oo[j][1] * rstd * nw[1] * siluf(bfhi(gv.x)));
            wv.y = pk2(oo[j][2] * rstd * nw[2] * siluf(bflo(gv.y)), oo[j][3] * rstd * nw[3] * siluf(bfhi(gv.y)));
            if (dost) *(u32x2*)gp = wv;
        }
    }
    __syncthreads();
}

__device__ __forceinline__ void scan_phase(const Ptrs& P, int tid) {
    constexpr int gsz = NGRID * 512;
    bf16_t* ST = (bf16_t*)(P.ws + WS_X); const float* decs = (const float*)((const unsigned char*)P.out + DO_SSDDEC);
    bf16_t* HS = (bf16_t*)((unsigned char*)P.out + DO_HGS); const float* dech = (const float*)((const unsigned char*)P.out + DO_HGDEC);
    for (int gid = blockIdx.x * 512 + tid; gid < 131072; gid += gsz) {
        const int bhs = gid >> 12, b = bhs >> 4, h = bhs & 15, idx = (gid & 4095) * 2;
        const int bh = gid >> 13, e = (gid & 8191) * 2, dk = e & 127;
        float r0 = 0.f, r1 = 0.f, q0 = 0.f, q1 = 0.f;
        for (int c0 = 0; c0 < NCH; c0 += 16) { unsigned v[16], w[16]; float d[16], f0[16], f1[16];
#pragma unroll
            for (int k = 0; k < 16; ++k) { const int ch = (c0 + k < NCH) ? c0 + k : NCH - 1;
                v[k] = *(const unsigned*)(ST + (size_t)((b * NCH + ch) * 16 + h) * 8192 + idx); d[k] = decs[(b * NCH + ch) * 16 + h];
                w[k] = *(const unsigned*)(HS + (size_t)(bh * NCH + ch) * 16384 + e); f0[k] = dech[(size_t)(bh * NCH + ch) * 128 + dk]; f1[k] = dech[(size_t)(bh * NCH + ch) * 128 + dk + 1]; }
#pragma unroll
            for (int k = 0; k < 16; ++k) { if (c0 + k < NCH) {
                *(unsigned*)(ST + (size_t)((b * NCH + c0 + k) * 16 + h) * 8192 + idx) = pk2(r0, r1); r0 = r0 * d[k] + bflo(v[k]); r1 = r1 * d[k] + bfhi(v[k]);
                *(unsigned*)(HS + (size_t)(bh * NCH + c0 + k) * 16384 + e) = pk2(q0, q1); q0 = q0 * f0[k] + bflo(w[k]); q1 = q1 * f1[k] + bfhi(w[k]); } } }
    }
}

__device__ __forceinline__ void ffn_act_phase(const Ptrs& P, int l, int half, int gw, int NGW, int lane) {
    const bf16_t* A2 = (const bf16_t*)(P.ws + WS_R); bf16_t* G2 = (bf16_t*)(P.ws + WS_R + (size_t)16640 * 11264 * 2);
    const float* cw = P.ffn_conv_w + (size_t)l * 3 * 2 * DFF; const float* cb = P.ffn_conv_b + (size_t)l * 2 * DFF;
    const int nblk = (half == 1) ? 513 : 512;
    for (int it = gw; it < nblk * 11; it += NGW) {
        const int rb = it / 11, cg = it - rb * 11, f0 = (cg * 64 + lane) * 8;
        float wg[3][8], wu[3][8], bg[8], bu[8];
#pragma unroll
        for (int k = 0; k < 3; ++k) { const f32x4 a = *(const f32x4*)(cw + k * 2 * DFF + f0), b2 = *(const f32x4*)(cw + k * 2 * DFF + f0 + 4), c = *(const f32x4*)(cw + k * 2 * DFF + DFF + f0), d = *(const f32x4*)(cw + k * 2 * DFF + DFF + f0 + 4);
#pragma unroll
            for (int e = 0; e < 4; ++e) { wg[k][e] = a[e]; wg[k][4 + e] = b2[e]; wu[k][e] = c[e]; wu[k][4 + e] = d[e]; } }
        { const f32x4 a = *(const f32x4*)(cb + f0), b2 = *(const f32x4*)(cb + f0 + 4), c = *(const f32x4*)(cb + DFF + f0), d = *(const f32x4*)(cb + DFF + f0 + 4);
#pragma unroll
          for (int e = 0; e < 4; ++e) { bg[e] = a[e]; bg[4 + e] = b2[e]; bu[e] = c[e]; bu[4 + e] = d[e]; } }
        const int lr0 = rb * 32; const bool meta = (rb == 512);
        u32x4 g2 = {0u, 0u, 0u, 0u}, g1 = g2, u2 = g2, u1 = g2;
        if (!meta) { const int r2 = (rb == 0) ? (SEQ + half * 16 + 14) : lr0 - 2, r1 = (rb == 0) ? (SEQ + half * 16 + 15) : lr0 - 1;
            g2 = *(const u32x4*)(A2 + (size_t)r2 * 11264 + f0); u2 = *(const u32x4*)(A2 + (size_t)r2 * 11264 + DFF + f0);
            g1 = *(const u32x4*)(A2 + (size_t)r1 * 11264 + f0); u1 = *(const u32x4*)(A2 + (size_t)r1 * 11264 + DFF + f0); }
        u32x4 gn[4], un[4];
#pragma unroll
        for (int i = 0; i < 4; ++i) { gn[i] = *(const u32x4*)(A2 + (size_t)(lr0 + i) * 11264 + f0); un[i] = *(const u32x4*)(A2 + (size_t)(lr0 + i) * 11264 + DFF + f0); }
#pragma unroll 1
        for (int i0 = 0; i0 < 32; i0 += 4) {
            u32x4 gc[4], uc[4];
#pragma unroll
            for (int i = 0; i < 4; ++i) { gc[i] = gn[i]; uc[i] = un[i]; }
            if (i0 + 4 < 32) {
#pragma unroll
                for (int i = 0; i < 4; ++i) { gn[i] = *(const u32x4*)(A2 + (size_t)(lr0 + i0 + 4 + i) * 11264 + f0); un[i] = *(const u32x4*)(A2 + (size_t)(lr0 + i0 + 4 + i) * 11264 + DFF + f0); } }
#pragma unroll
            for (int i = 0; i < 4; ++i) {
                if (meta && ((i0 + i) & 15) == 0) { g2 = (u32x4){0u, 0u, 0u, 0u}; g1 = g2; u2 = g2; u1 = g2; }
                float a2[8], a1[8], a0[8], c2[8], c1[8], c0[8], o[8];
                unpack8(g2, a2); unpack8(g1, a1); unpack8(gc[i], a0); unpack8(u2, c2); unpack8(u1, c1); unpack8(uc[i], c0);
#pragma unroll
                for (int e = 0; e < 8; ++e) { const float gv = bg[e] + wg[0][e] * a2[e] + wg[1][e] * a1[e] + wg[2][e] * a0[e]; const float uv = bu[e] + wu[0][e] * c2[e] + wu[1][e] * c1[e] + wu[2][e] * c0[e]; o[e] = siluf(gv) * uv; }
                u32x4 wv; wv.x = pk2(o[0], o[1]); wv.y = pk2(o[2], o[3]); wv.z = pk2(o[4], o[5]); wv.w = pk2(o[6], o[7]);
                *(u32x4*)(G2 + (size_t)(lr0 + i0 + i) * DFF + f0) = wv;
                g2 = g1; g1 = gc[i]; u2 = u1; u1 = uc[i];
            }
        }
    }
}

#define XB_TMO      128
#define XB_XCNT(j)  (256  + 64 * (j))
#define XB_XSUB(j)  (1280 + 64 * (j))
#define XB_XGEN(j)  (2304 + 64 * (j))
#define XB_TOP      3328
#define XB_TOPGEN   3392
#define XCD_BAR_WORDS 3456
#define XB_SPIN_CAP (1u << 18)

__device__ __forceinline__ unsigned xb_ld(unsigned* p)              { return __hip_atomic_load(p, __ATOMIC_RELAXED, __HIP_MEMORY_SCOPE_AGENT); }
__device__ __forceinline__ unsigned xb_add(unsigned* p, unsigned v) { return __hip_atomic_fetch_add(p, v, __ATOMIC_RELAXED, __HIP_MEMORY_SCOPE_AGENT); }
__device__ __forceinline__ unsigned xb_xcc_id() { return (unsigned)__builtin_amdgcn_s_getreg((3 << 11) | 20) & 0xFu; }
#define XB_SPIN(cond, bar) do { unsigned _sp = 0; while (cond) { __builtin_amdgcn_s_sleep(1); \
    if ((++_sp & 255u) == 0u) { if (xb_ld(&(bar)[XB_TMO])) break; if (_sp > XB_SPIN_CAP) { atomicAdd(&(bar)[XB_TMO], 1u); break; } } } } while (0)

struct XcdBarrier {
    unsigned* bar; unsigned x;
    volatile LAS unsigned* st;
};

__device__ __forceinline__ XcdBarrier xcd_barrier_post(unsigned* bar, volatile LAS unsigned* st) {
    XcdBarrier b; b.bar = bar; b.x = xb_xcc_id(); b.st = st;
    if (threadIdx.x == 0) (void)xb_add(&bar[XB_XCNT(b.x)], 1u);
    return b;
}
__device__ __forceinline__ void xcd_barrier_complete(unsigned* bar, unsigned x, unsigned& nloc, unsigned& nx) {
    const unsigned G = gridDim.x * gridDim.y * gridDim.z;
    unsigned sum, cnt, mine, sp = 0u;
    for (;;) {
        sum = 0u; cnt = 0u; mine = 0u;
#pragma unroll
        for (unsigned j = 0; j < 16; ++j) { const unsigned c = xb_ld(&bar[XB_XCNT(j)]); sum += c; cnt += (c > 0u) ? 1u : 0u; mine = (j == x) ? c : mine; }
        if (sum == G) break;
        __builtin_amdgcn_s_sleep(1);
        if ((++sp & 255u) == 0u) { if (xb_ld(&bar[XB_TMO])) break; if (sp > XB_SPIN_CAP) { atomicAdd(&bar[XB_TMO], 1u); break; } }
    }
    nloc = mine > 0u ? mine : 1u; nx = cnt > 0u ? cnt : 1u;
}

__device__ __forceinline__ void xcd_barrier(const XcdBarrier& b) {
    asm volatile("s_waitcnt vmcnt(0)" ::: "memory");
    __syncthreads();
    if (pg8::wg_tid((PG8_LAS unsigned char*)b.st - (LDS_BYTES - 16)) == 0) {
        unsigned* bar = b.bar;
        __builtin_amdgcn_s_waitcnt(0);
        unsigned nloc = b.st[0], nx = b.st[1];
        if (nloc == 0u) { xcd_barrier_complete(bar, b.x, nloc, nx); b.st[0] = nloc; b.st[1] = nx; }
        const unsigned old = xb_add(&bar[XB_XSUB(b.x)], 1u);
        const unsigned gen = old / nloc;
        if (old + 1u == (gen + 1u) * nloc) {
            __builtin_amdgcn_fence(__ATOMIC_RELEASE, "agent");
            asm volatile("s_waitcnt vmcnt(0)" ::: "memory");
            const unsigned og = xb_add(&bar[XB_TOP], 1u);
            const unsigned tg = og / nx;
            if (og + 1u == (tg + 1u) * nx) xb_add(&bar[XB_TOPGEN], 1u);
            else XB_SPIN(xb_ld(&bar[XB_TOPGEN]) == tg, bar);
            __builtin_amdgcn_fence(__ATOMIC_ACQUIRE, "agent");
            xb_add(&bar[XB_XGEN(b.x)], 1u);
            asm volatile("s_waitcnt vmcnt(0)" ::: "memory");
        } else {
            XB_SPIN(xb_ld(&bar[XB_XGEN(b.x)]) == gen, bar);
            __builtin_amdgcn_fence(__ATOMIC_ACQUIRE, "agent");
            asm volatile("s_waitcnt vmcnt(0)" ::: "memory");
        }
    }
    __syncthreads();
}

typedef float f32x16 __attribute__((ext_vector_type(16)));
template <int MODE, int NSEL> __device__ __forceinline__ void skinny_phase(const bf16_t* A, int lda, size_t asel, const bf16_t* Bt, size_t bsel, int K, int N, unsigned char* lds, int tid, int bx, int G,
                                                                          const bf16_t* GT, bf16_t* Ob, int ldo, bf16_t* H) {
    const int lane = tid & 63, w = tid >> 6, kw = K >> 3;
    float* red = (float*)lds;
    for (int blk = G - 1 - bx; blk < (N >> 5); blk += G) {
#pragma unroll
        for (int s = 0; s < NSEL; ++s) {
            const bf16_t* ap = A + s * asel + (size_t)(lane & 31) * lda + w * kw + 8 * (lane >> 5);
            const bf16_t* bp = Bt + s * bsel + (size_t)(blk * 32 + (lane & 31)) * K + w * kw + 8 * (lane >> 5);
            f32x16 acc;
#pragma unroll
            for (int i = 0; i < 16; ++i) acc[i] = 0.f;
#pragma unroll 8
            for (int k = 0; k < kw; k += 16) { const bf16x8 bv = *(const bf16x8*)(bp + k); const bf16x8 av = *(const bf16x8*)(ap + k); acc = __builtin_amdgcn_mfma_f32_32x32x16_bf16(bv, av, acc, 0, 0, 0); }
#pragma unroll
            for (int i = 0; i < 16; ++i) red[((s * 8 + w) * 16 + i) * 64 + lane] = acc[i];
        }
        __syncthreads();
        const int row = lane & 31, col = blk * 32 + 8 * (w >> 1) + 4 * (lane >> 5) + 2 * (w & 1);
        float v[NSEL][2];
#pragma unroll
        for (int s = 0; s < NSEL; ++s)
#pragma unroll
            for (int e = 0; e < 2; ++e) { float t = 0.f;
#pragma unroll
                for (int ww = 0; ww < 8; ++ww) t += red[((s * 8 + ww) * 16 + 2 * w + e) * 64 + lane]; v[s][e] = t; }
        if (MODE == 1) { *(unsigned*)(Ob + (size_t)row * ldo + col) = pk2(sigm(v[0][0]), sigm(v[0][1])); }
        else if (MODE == 2) { float o0 = 0.f, o1 = 0.f;
#pragma unroll
            for (int s = 0; s < NSEL; ++s) { const unsigned gwd = *(const unsigned*)(GT + (size_t)row * 6144 + s * 2048 + col); o0 += bflo(gwd) * v[s][0]; o1 += bfhi(gwd) * v[s][1]; }
            *(unsigned*)(Ob + (size_t)(MMAIN + row) * ldo + col) = pk2(o0, o1); }
        else if (MODE == 3) { unsigned* hp = (unsigned*)(H + (size_t)(MMAIN + row) * DM + col); const unsigned hw = *hp; *hp = pk2(bflo(hw) + v[0][0], bfhi(hw) + v[0][1]); }
        else { *(unsigned*)(Ob + (size_t)(16384 + row) * ldo + col) = pk2(v[0][0], v[0][1]); }
        __syncthreads();
    }
}

#ifndef GEMM_ALIGN
#define GEMM_ALIGN true
#endif
#ifndef GEMM_SP2
#define GEMM_SP2 true
#endif
#ifndef REP_ATT
#define REP_ATT 1
#endif
#ifndef REP_MIXB
#define REP_MIXB 1
#endif
#ifndef REP_SKIPSSD
#define REP_SKIPSSD 0
#endif
#ifndef REP_G1
#define REP_G1 1
#endif
#ifndef REP_MIXA
#define REP_MIXA 1
#endif
#ifndef REP_MEM
#define REP_MEM 1
#endif
#ifndef REP_SYNC
#define REP_SYNC 1
#endif
#define GSYNC() do { for (int rs_ = 0; rs_ < REP_SYNC; ++rs_) xcd_barrier(xbar); } while (0)
#ifndef PH_MASK
#define PH_MASK 0xFFFFF
#endif
#define PH(b) ((PH_MASK >> (b)) & 1)
typedef const __attribute__((address_space(4))) Ptrs* KPtr;
__global__ void __launch_bounds__(512, 2) fwd_megakernel(Ptrs Parg) {
    extern __shared__ __attribute__((aligned(16))) unsigned char lds[];
    cg::grid_group grid = cg::this_grid();
    constexpr int G = NGRID, NGW = NGRID * 8; const int bx = blockIdx.x;
    PG8_LAS unsigned char* glds = (PG8_LAS unsigned char*)lds;
    volatile LAS unsigned* misc = (volatile LAS unsigned*)((LAS unsigned char*)lds + (LDS_BYTES - 16));
    if (threadIdx.x < 4) misc[threadIdx.x] = 0u;
    if ((threadIdx.x & 63) == 0) { const unsigned hw = (unsigned)__builtin_amdgcn_s_getreg((5 << 11) | 4) & 63u; ((volatile LAS unsigned*)((LAS unsigned char*)lds + pg8::WMAP_OFF))[hw] = threadIdx.x >> 6; }
    __syncthreads();
    const XcdBarrier xbar = xcd_barrier_post((unsigned*)Parg.ws, misc);
    grid.sync();
#define TIDS const int tid = pg8::wg_tid(glds); const int lane = tid & 63, wave = tid >> 6, gw = bx * 8 + wave; (void)lane; (void)gw; (void)wave; PHP
#define PHP KPtr kp_ = (KPtr)__builtin_amdgcn_kernarg_segment_ptr(); asm volatile("" : "+s"(kp_)); Ptrs P; __builtin_memcpy(&P, (const void*)kp_, sizeof(Ptrs)); \
    unsigned char* dob = (unsigned char*)P.out; bf16_t* U = (bf16_t*)(P.ws + WS_U); bf16_t* PJ = (bf16_t*)(P.ws + WS_R); bf16_t* H = (bf16_t*)(P.ws + WS_H); \
    bf16_t* WinT = (bf16_t*)(dob + DO_WIN); bf16_t* WgT = (bf16_t*)(dob + DO_WG); bf16_t* WbT = (bf16_t*)(dob + DO_WB); bf16_t* WoT = (bf16_t*)(dob + DO_WO); \
    bf16_t* WupT = (bf16_t*)(dob + DO_WUP); bf16_t* WdT = (bf16_t*)(dob + DO_WD); bf16_t* GT = (bf16_t*)(P.ws + WS_X); \
    (void)U; (void)PJ; (void)H; (void)WinT; (void)WgT; (void)WbT; (void)WoT; (void)WupT; (void)WdT; (void)GT

    for (int l = 0; l < 2; ++l) {
        for (int rep = 0; rep < REP_MEM; ++rep) if (PH(0)) { TIDS; convert_weights(P, l, lds, gw, NGW, lane, wave); }
        for (int rep = 0; rep < REP_MEM; ++rep) if (PH(1)) { TIDS; if (l == 0) norm_phase<1>(P, P.attn_norm_w, gw, NGW, lane); else norm_phase<0>(P, P.attn_norm_w + l * DM, gw, NGW, lane); }
        GSYNC();
        for (int rep = 0; rep < REP_G1; ++rep) if (PH(2)) { PHP; pg8::Gemm g{U, WinT, DM, DM, 0, 0, 0}; pg8::Sched S{129, PW / 256, 1, G, bx, 0, 129};
          pg8::EpiStore<0> E{PJ, PW, 0};
          pg8::gemm_phase<pg8::EpiStore<0>, pg8::Sched, GEMM_ALIGN, GEMM_SP2>(glds, g, S, E); }
        if (PH(3)) { TIDS; dt_phase(P, gw, NGW, lane); }
        GSYNC();
        if (PH(4)) { TIDS; attn_tables(P, lds, tid);
          unsigned* qctr = (unsigned*)P.ws + 8192 + 64 * (2 * l);
          unsigned nxt = 0u; if (tid == 0) misc[2] = atomicAdd(qctr, 1u);
          __syncthreads();
          int it = (int)__builtin_amdgcn_readfirstlane(misc[2]);
          while (it < 28 * NCH) { const int t2 = pg8::wg_tid(glds);
              if (t2 == 0) nxt = atomicAdd(qctr, 1u);
              if (it < 16 * NCH) { const int ch = it % NCH, bh = it / NCH; hg_unit(P, l, bh >> 3, bh & 7, ch, lds, t2); }
              else if (it < 24 * NCH) { const int i2 = it - 16 * NCH; const int ch = i2 % NCH, bg = i2 / NCH; ssd_passA(P, l, bg >> 2, ch, bg & 3, lds, t2); }
              else { const int i2 = it - 24 * NCH; const int n = i2 % NCH, bg = i2 / NCH; attn_unit(P, l, bg >> 1, bg & 1, n, lds, t2, true); }
              if (t2 == 0) misc[2] = nxt;
              __syncthreads();
              it = (int)__builtin_amdgcn_readfirstlane(misc[2]); } }
        GSYNC();
        if (PH(7)) { TIDS; scan_phase(P, tid); }
        GSYNC();
        if (PH(8)) { TIDS;
          unsigned* qctr = (unsigned*)P.ws + 8192 + 64 * (2 * l + 1);
          unsigned nxt = 0u; if (tid == 0) misc[2] = atomicAdd(qctr, 1u);
          __syncthreads();
          int it = (int)__builtin_amdgcn_readfirstlane(misc[2]);
          while (it < 24 * NCH) { const int t2 = pg8::wg_tid(glds);
              if (t2 == 0) nxt = atomicAdd(qctr, 1u);
              if (it < 8 * NCH) { const int ch = it % NCH, bg = it / NCH; ssd_passB(P, l, bg >> 2, ch, bg & 3, lds, t2, true); }
              else { const int i2 = it - 8 * NCH; const int ch = i2 % NCH, bh = i2 / NCH; hg_passB(P, l, bh >> 3, bh & 7, ch, lds, t2, true); }
              if (t2 == 0) misc[2] = nxt;
              __syncthreads();
              it = (int)__builtin_amdgcn_readfirstlane(misc[2]); } }
        GSYNC();
        if (PH(10)) { PHP; pg8::Gemm g{U, WgT, DM, DM, 0, 0, 0}; pg8::Sched S{128, 24, 1, G, bx, 0, 128};
          pg8::EpiGate E{pg8::GateMap{PJ + C_HQ, GT, (bf16_t*)(dob + DO_GB)}};
          pg8::gemm_phase<pg8::EpiGate, pg8::Sched, GEMM_ALIGN, GEMM_SP2>(glds, g, S, E); }
        { TIDS; skinny_phase<1, 1>(U + (size_t)MMAIN * DM, DM, 0, WgT, 0, DM, 6144, lds, tid, bx, G, nullptr, (bf16_t*)(dob + DO_GMETA), 6144, nullptr); }
        GSYNC();
        if (PH(11)) { PHP; pg8::Gemm g{PJ + C_AQ, WbT, 1024, PW, 0, (size_t)1024, (size_t)DM * 1024}; pg8::Sched S{128, 8, 3, G, bx, 0, 128};
          pg8::EpiMerge E{pg8::GateMap{PJ + C_HQ, GT, (bf16_t*)(dob + DO_GB)}, PJ + C_XBC, PW};
          pg8::gemm_phase<pg8::EpiMerge, pg8::Sched, GEMM_ALIGN, GEMM_SP2>(glds, g, S, E); }
        { TIDS; skinny_phase<2, 3>(PJ + (size_t)MMAIN * PW + C_AQ, PW, 1024, WbT, (size_t)DM * 1024, 1024, DM, lds, tid, bx, G, (const bf16_t*)(dob + DO_GMETA), PJ + C_XBC, PW, nullptr); }
        GSYNC();
        if (PH(12)) { PHP; pg8::Gemm g{PJ + C_XBC, WoT, DM, PW, 0, 0, 0}; pg8::Sched S{128, 8, 1, G, bx, 0, 128};
          pg8::EpiResid E{H};
          pg8::gemm_phase<pg8::EpiResid, pg8::Sched, GEMM_ALIGN, GEMM_SP2>(glds, g, S, E); }
        { TIDS; skinny_phase<3, 1>(PJ + (size_t)MMAIN * PW + C_XBC, PW, 0, WoT, 0, DM, DM, lds, tid, bx, G, nullptr, nullptr, 0, H); }
        GSYNC();
        if (PH(13)) { TIDS; norm_phase<0>(P, P.ffn_norm_w + l * DM, gw, NGW, lane); }
        GSYNC();
        for (int half = 0; half < 2; ++half) {
            if (PH(14)) { PHP; bf16_t* A2 = PJ; pg8::Gemm g{U, WupT, DM, DM, 0, 0, 0}; pg8::Sched S{64, 44, 1, G, bx, 64 * half, 64};
              pg8::EpiStore<0> E{A2, 11264, 1};
              pg8::gemm_phase<pg8::EpiStore<0>, pg8::Sched, GEMM_ALIGN, GEMM_SP2>(glds, g, S, E); }
            if (half == 0) { TIDS; skinny_phase<4, 1>(U + (size_t)MMAIN * DM, DM, 0, WupT, 0, DM, 2 * DFF, lds, tid, bx, G, nullptr, PJ, 2 * DFF, nullptr); }
            GSYNC();
            for (int rep = 0; rep < REP_MEM; ++rep) if (PH(15)) { TIDS; ffn_act_phase(P, l, half, gw, NGW, lane); }
            GSYNC();
            if (PH(16)) { PHP; bf16_t* G2 = (bf16_t*)(P.ws + WS_R + (size_t)16640 * 11264 * 2); pg8::Gemm g{G2, WdT, DFF, DFF, 1, 0, 0}; pg8::Sched S{64, 8, 1, G, bx, 64 * half, 64};
              pg8::EpiResid E{H};
              pg8::gemm_phase<pg8::EpiResid, pg8::Sched, GEMM_ALIGN, GEMM_SP2>(glds, g, S, E); }
            if (half == 1) { TIDS; skinny_phase<3, 1>((const bf16_t*)(P.ws + WS_R + (size_t)16640 * 11264 * 2) + (size_t)16384 * DFF, DFF, 0, WdT, 0, DFF, DM, lds, tid, bx, G, nullptr, nullptr, 0, H); }
            GSYNC();
        }
    }
    if (PH(17)) { TIDS; norm_phase<2>(P, P.final_norm_w, gw, NGW, lane); }
}

extern "C" void kernel_launch(void* const* d_in, const int* in_sizes, int n_in, void* d_out, int out_size, void* d_ws, size_t ws_size, hipStream_t stream) {
    static int grid = 0;
    if (grid == 0) {
        if (n_in != 22 || ws_size < WS_NEED) { fprintf(stderr, "kernel_launch: unexpected n_in %d or workspace %zu < %zu\n", n_in, ws_size, (size_t)WS_NEED); grid = -1; return; }
        int dev = 0, cus = 0, per_cu = 0;
        hipGetDevice(&dev); hipDeviceGetAttribute(&cus, hipDeviceAttributeMultiprocessorCount, dev);
        if (hipFuncSetAttribute((const void*)fwd_megakernel, hipFuncAttributeMaxDynamicSharedMemorySize, LDS_BYTES) != hipSuccess) { fprintf(stderr, "hipFuncSetAttribute failed\n"); }
        if (hipOccupancyMaxActiveBlocksPerMultiprocessor(&per_cu, (const void*)fwd_megakernel, 512, LDS_BYTES) != hipSuccess || per_cu < 1) per_cu = 1;
        (void)hipGetLastError();
        grid = NGRID; if (cus < NGRID) { fprintf(stderr, "kernel_launch: built for %d CUs, device has %d\n", NGRID, cus); grid = -1; return; }
    }
    if (grid < 0) return;
    if (hipMemsetAsync(d_ws, 0, 65536, stream) != hipSuccess) { fprintf(stderr, "memset failed\n"); return; }
    Ptrs p{};
    const float** pp = (const float**)&p;
    for (int i = 0; i < 22; ++i) pp[i] = (const float*)d_in[i];
    p.out = (float*)d_out; p.ws = (unsigned char*)d_ws;
    void* args[] = {&p};
    hipError_t e = hipLaunchCooperativeKernel((const void*)fwd_megakernel, dim3(grid), dim3(512), args, LDS_BYTES, stream);
    if (e != hipSuccess) fprintf(stderr, "cooperative launch failed: %s (grid %d)\n", hipGetErrorString(e), grid);
}
```

```cpp
#include <hip/hip_runtime.h>
#include <hip/hip_cooperative_groups.h>
#include <cstdio>
#include <cstdint>
namespace cg = cooperative_groups;

namespace pg8 {
#define PG8_LAS __attribute__((address_space(3)))
constexpr int WMAP_OFF = 163840 - 16 - 256;
__device__ __forceinline__ int wg_tid(PG8_LAS unsigned char* ldsbase) {
    const unsigned hw = (unsigned)__builtin_amdgcn_s_getreg((5 << 11) | 4) & 63u;
    const unsigned wv = ((volatile PG8_LAS unsigned*)(ldsbase + WMAP_OFF))[hw];
    const int lane = (int)__builtin_amdgcn_mbcnt_hi(~0u, __builtin_amdgcn_mbcnt_lo(~0u, 0u));
    int t = (int)__builtin_amdgcn_readfirstlane(wv) * 64 + lane;
    asm volatile("" : "+v"(t));
    return t;
}
typedef unsigned short bf16_t;
typedef short bf16x8 __attribute__((ext_vector_type(8)));
typedef float f32x4 __attribute__((ext_vector_type(4)));
typedef unsigned u32x4 __attribute__((ext_vector_type(4)));
constexpr int BM = 256, BK = 64, HALF = 128, HTB = HALF * BK * 2, STAGE_BYTES = 8 * HTB, NXCD = 8, WGM = 8;

__host__ __device__ __forceinline__ int lds_byte(int r, int c) { const int st = (r >> 4) * 2 + (c >> 5), rr = r & 15, cc = c & 31, ob = rr * 64 + cc * 2; return st * 1024 + (ob ^ (((ob >> 9) & 1) << 5)); }
__host__ __device__ __forceinline__ void stage_rc(int b, int& R, int& C) { const int st = b / 1024, sb = b % 1024, swz = sb ^ (((sb >> 9) & 1) << 5); R = (st >> 1) * 16 + swz / 64; C = (st & 1) * 32 + (swz % 64) / 2; }
__host__ __device__ __forceinline__ int perm32(int rho) { const int n = rho >> 4, i = rho & 15; return 8 * (i >> 2) + 4 * n + (i & 3); }

struct Unit { int pm, pn, sel, lpm; };
struct Gemm { const bf16_t* A; const bf16_t* Bt; int K, lda, alocal; size_t asel, bsel; };

struct Sched {
    int nM, nN, nsel, G, c, pm0, nMain;
    __device__ __forceinline__ bool next(int i, Unit& u) const {
        const int nwg = nM * nN; const int L = (i / nsel) * G + c; if (L >= nwg) return false;
        int wgid = L; { const int q = nwg / NXCD, r = nwg % NXCD, xcd = wgid % NXCD, off = wgid / NXCD; wgid = (xcd < r ? xcd * (q + 1) : r * (q + 1) + (xcd - r) * q) + off; }
        const int nig = WGM * nN, gid = wgid / nig, fm = gid * WGM, gsz = (nM - fm) < WGM ? (nM - fm) : WGM;
        u.lpm = fm + ((wgid % nig) % gsz); u.pn = (wgid % nig) / gsz; u.sel = i % nsel; u.pm = (u.lpm < nMain) ? (pm0 + u.lpm) : 128; return true;
    }
    __device__ __forceinline__ void a_ready(const Unit&) const {}
    __device__ __forceinline__ void done(const Unit&) const {}
};
typedef float f32x2_t __attribute__((ext_vector_type(2))); typedef __bf16 bf16x2_t __attribute__((ext_vector_type(2)));
__device__ __forceinline__ unsigned pk2_(float lo, float hi) { f32x2_t v = {lo, hi}; bf16x2_t b = __builtin_convertvector(v, bf16x2_t); return __builtin_bit_cast(unsigned, b); }
__device__ __forceinline__ float bflo(unsigned w) { return __builtin_bit_cast(float, w << 16); }
__device__ __forceinline__ float bfhi(unsigned w) { return __builtin_bit_cast(float, w & 0xffff0000u); }
__device__ __forceinline__ float sigm(float x) { return __builtin_amdgcn_rcpf(1.0f + __expf(-x)); }

typedef unsigned u32x2w __attribute__((ext_vector_type(2)));
__device__ __forceinline__ void store8_wt(void* p, u32x2w v) { asm volatile("global_store_dwordx2 %0, %1, off sc1\n\ts_nop 1" :: "v"(p), "v"(v) : "memory"); }
__device__ __forceinline__ void store16_wt(void* p, u32x4 v) { asm volatile("global_store_dwordx4 %0, %1, off sc1\n\ts_nop 1" :: "v"(p), "v"(v) : "memory"); }
template <int ACT  > struct EpiStore {
    static constexpr bool PERM = true, AFTER_DRAIN = false;
    bf16_t* O; int ldc; int local;
    __device__ __forceinline__ void operator()(const f32x4 (&acc)[2][2][4][2], const Unit& u, int wr, int wc, int fr, int fq) const {
        const int row0 = (local ? u.lpm : u.pm) * BM + wr * 64 + fr; const int col0 = u.pn * BM + wc * 32 + 8 * fq;
#pragma unroll
        for (int ai = 0; ai < 2; ++ai)
#pragma unroll
            for (int m = 0; m < 4; ++m) { bf16_t* rowp = O + (size_t)(row0 + ai * HALF + m * 16) * ldc + col0;
#pragma unroll
                for (int bj = 0; bj < 2; ++bj) { f32x4 v0 = acc[ai][bj][m][0], v1 = acc[ai][bj][m][1];
                    if (ACT == 1) { v0 = (f32x4){sigm(v0[0]), sigm(v0[1]), sigm(v0[2]), sigm(v0[3])}; v1 = (f32x4){sigm(v1[0]), sigm(v1[1]), sigm(v1[2]), sigm(v1[3])}; }
                    u32x4 w; w.x = pk2_(v0[0], v0[1]); w.y = pk2_(v0[2], v0[3]); w.z = pk2_(v1[0], v1[1]); w.w = pk2_(v1[2], v1[3]);
                    store16_wt(rowp + bj * HALF, w); } }
    }
};
struct GateMap { bf16_t* PJg; bf16_t* Xa; bf16_t* Xb;
    __device__ __forceinline__ bf16_t* at(int pm, int rl, int gt  , int c) const {
        if (gt < 12) return PJg + (size_t)(pm * BM + rl) * 8448 + gt * BM + c;
        return (pm < 64 ? Xa + (size_t)(pm * BM + rl) * 3072 : Xb + (size_t)((pm - 64) * BM + rl) * 3072) + (gt - 12) * BM + c; } };
struct EpiGate {
    static constexpr bool PERM = true, AFTER_DRAIN = false;
    GateMap gm;
    __device__ __forceinline__ void operator()(const f32x4 (&acc)[2][2][4][2], const Unit& u, int wr, int wc, int fr, int fq) const {
        const int c0 = wc * 32 + 8 * fq;
#pragma unroll
        for (int ai = 0; ai < 2; ++ai)
#pragma unroll
            for (int m = 0; m < 4; ++m) { bf16_t* rowp = gm.at(u.pm, wr * 64 + fr + ai * HALF + m * 16, u.pn, c0);
#pragma unroll
                for (int bj = 0; bj < 2; ++bj) { const f32x4 v0 = acc[ai][bj][m][0], v1 = acc[ai][bj][m][1];
                    u32x4 w; w.x = pk2_(sigm(v0[0]), sigm(v0[1])); w.y = pk2_(sigm(v0[2]), sigm(v0[3])); w.z = pk2_(sigm(v1[0]), sigm(v1[1])); w.w = pk2_(sigm(v1[2]), sigm(v1[3]));
                    store16_wt(rowp + bj * HALF, w); } }
    }
};
struct EpiMerge {
    static constexpr bool PERM = true, AFTER_DRAIN = false;
    GateMap gm; bf16_t* Mg; int ldm;
    __device__ __forceinline__ void operator()(const f32x4 (&acc)[2][2][4][2], const Unit& u, int wr, int wc, int fr, int fq) const {
        const int col0 = u.pn * BM + wc * 32 + 8 * fq;
#pragma unroll
        for (int ai = 0; ai < 2; ++ai) {
            u32x4 gw[4][2], ow[4][2];
#pragma unroll
            for (int m = 0; m < 4; ++m) { const int rl = wr * 64 + fr + ai * HALF + m * 16;
                const bf16_t* gp = gm.at(u.pm, rl, u.sel * 8 + u.pn, wc * 32 + 8 * fq); const bf16_t* mp2 = Mg + (size_t)(u.pm * BM + rl) * ldm + col0;
#pragma unroll
                for (int bj = 0; bj < 2; ++bj) { gw[m][bj] = *(const u32x4*)(gp + bj * HALF); ow[m][bj] = (u32x4){0u, 0u, 0u, 0u}; if (u.sel > 0) ow[m][bj] = *(const u32x4*)(mp2 + bj * HALF); } }
#pragma unroll
            for (int m = 0; m < 4; ++m) { const int rl = wr * 64 + fr + ai * HALF + m * 16; bf16_t* mp2 = Mg + (size_t)(u.pm * BM + rl) * ldm + col0;
#pragma unroll
                for (int bj = 0; bj < 2; ++bj) { const f32x4 v0 = acc[ai][bj][m][0], v1 = acc[ai][bj][m][1]; const u32x4 g = gw[m][bj], o = ow[m][bj];
                    u32x4 w; w.x = pk2_(bflo(o.x) + bflo(g.x) * v0[0], bfhi(o.x) + bfhi(g.x) * v0[1]); w.y = pk2_(bflo(o.y) + bflo(g.y) * v0[2], bfhi(o.y) + bfhi(g.y) * v0[3]);
                    w.z = pk2_(bflo(o.z) + bflo(g.z) * v1[0], bfhi(o.z) + bfhi(g.z) * v1[1]); w.w = pk2_(bflo(o.w) + bflo(g.w) * v1[2], bfhi(o.w) + bfhi(g.w) * v1[3]);
                    *(u32x4*)(mp2 + bj * HALF) = w; } }
            asm volatile("" ::: "memory");
        }
    }
};
struct EpiResid {
    static constexpr bool PERM = false, AFTER_DRAIN = false;
    bf16_t* H;
    __device__ __forceinline__ void operator()(const f32x4 (&acc)[2][2][4][2], const Unit& u, int wr, int wc, int fr, int fq) const {
        typedef unsigned u32x2_ __attribute__((ext_vector_type(2)));
        const int col0 = u.pn * BM + wc * 32 + 4 * fq;
#pragma unroll
        for (int ai = 0; ai < 2; ++ai) {
            u32x2_ v[4][2][2];
#pragma unroll
            for (int m = 0; m < 4; ++m) { const bf16_t* rowp = H + (size_t)(u.pm * BM + wr * 64 + fr + ai * HALF + m * 16) * 2048 + col0;
#pragma unroll
                for (int bj = 0; bj < 2; ++bj)
#pragma unroll
                    for (int n = 0; n < 2; ++n) v[m][bj][n] = *(const u32x2_*)(rowp + bj * HALF + n * 16); }
#pragma unroll
            for (int m = 0; m < 4; ++m) { bf16_t* rowp = H + (size_t)(u.pm * BM + wr * 64 + fr + ai * HALF + m * 16) * 2048 + col0;
#pragma unroll
                for (int bj = 0; bj < 2; ++bj)
#pragma unroll
                    for (int n = 0; n < 2; ++n) { const f32x4 a = acc[ai][bj][m][n]; const u32x2_ o = v[m][bj][n];
                        u32x2_ w; w.x = pk2_(bflo(o.x) + a[0], bfhi(o.x) + a[1]); w.y = pk2_(bflo(o.y) + a[2], bfhi(o.y) + a[3]); *(u32x2_*)(rowp + bj * HALF + n * 16) = w; } }
            asm volatile("" ::: "memory");
        }
    }
};

template <class Epi, class Sched, bool ALIGN_EPI = false, bool SP2 = false>
__device__ __forceinline__ void gemm_phase(PG8_LAS unsigned char* lds, const Gemm g, const Sched& S, const Epi& E) {
    const int tid0_ = wg_tid(lds);
    const int tid = tid0_, wid = __builtin_amdgcn_readfirstlane(tid >> 6), lane = tid & 63, wr = wid >> 2, wc = wid & 3, fr = lane & 15, fq = lane >> 4;
    const int K = g.K, nt = K / BK, lda = g.lda;
    unsigned voffA[2], voffB[2];
#pragma unroll
    for (int i = 0; i < 2; ++i) { int R, C; stage_rc(tid * 16 + i * 8192, R, C); const int Rb = Epi::PERM ? ((R & ~31) + perm32(R & 31)) : R;
        voffA[i] = (unsigned)(R * lda + C) * 2u; voffB[i] = (unsigned)(Rb * K + C) * 2u; }
    const size_t kstep = (size_t)(BK * 2);
    const size_t hstepA = (size_t)HALF * lda * 2, hstepB = (size_t)HALF * K * 2;
    const unsigned ldsw = (unsigned)wid * 1024u;
    const int aoff = lds_byte(wr * 64 + fr, fq * 8), boff = lds_byte(wc * 32 + fr, fq * 8);
#define PG8_SA(b, h) (((b) * 2 + (h)) * HTB)
#define PG8_SB(b, h) ((4 + (b) * 2 + (h)) * HTB)
#define PG8_STAGE(bufoff, gbase, voff) do { _Pragma("unroll") for (int _i = 0; _i < 2; ++_i) \
        __builtin_amdgcn_global_load_lds((const unsigned*)((const char*)(gbase) + (voff)[_i]), (PG8_LAS unsigned*)(lds + (bufoff) + ldsw + _i * 8192), 16, 0, 0); } while (0)
#define PG8_LDA(dst, b, h) do { _Pragma("unroll") for (int m = 0; m < 4; ++m) _Pragma("unroll") for (int k = 0; k < 2; ++k) dst[m][k] = *(const PG8_LAS bf16x8*)(lds + PG8_SA(b, h) + aoff + m * 2048 + k * 1024); } while (0)
#define PG8_LDB(dst, b, h) do { _Pragma("unroll") for (int n = 0; n < 2; ++n) _Pragma("unroll") for (int k = 0; k < 2; ++k) dst[n][k] = *(const PG8_LAS bf16x8*)(lds + PG8_SB(b, h) + boff + n * 2048 + k * 1024); } while (0)
#define PG8_MMA(ai, bj, At, Bt) do { __builtin_amdgcn_s_setprio(1); _Pragma("unroll") for (int m = 0; m < 4; ++m) _Pragma("unroll") for (int n = 0; n < 2; ++n) _Pragma("unroll") for (int k = 0; k < 2; ++k) \
        acc[ai][bj][m][n] = __builtin_amdgcn_mfma_f32_16x16x32_bf16(Bt[n][k], At[m][k], acc[ai][bj][m][n], 0, 0, 0); __builtin_amdgcn_s_setprio(0); } while (0)
#define PG8_WAIT_V(n) asm volatile("s_waitcnt vmcnt(" #n ")" ::: "memory")
#define PG8_WAIT_L(n) asm volatile("s_waitcnt lgkmcnt(" #n ")" ::: "memory")
#define PG8_BAR __builtin_amdgcn_s_barrier()
#define PG8_SCHED __builtin_amdgcn_sched_barrier(0)
#define PG8_UA(u) ((const char*)g.A + ((size_t)(g.alocal ? (u).lpm : (u).pm) * 256 * (size_t)lda + (size_t)(u).sel * g.asel) * 2)
#define PG8_UB(u) ((const char*)g.Bt + ((size_t)(u).pn * 256 * (size_t)K + (size_t)(u).sel * g.bsel) * 2)
    Unit cur, nxt; int ui = 0;
    if (!S.next(0, cur)) return;
    f32x4 acc[2][2][4][2];
#pragma unroll
    for (int a = 0; a < 2; ++a)
#pragma unroll
        for (int b = 0; b < 2; ++b)
#pragma unroll
            for (int m = 0; m < 4; ++m)
#pragma unroll
                for (int n = 0; n < 2; ++n) acc[a][b][m][n] = (f32x4){0.f, 0.f, 0.f, 0.f};
    bf16x8 At[4][2], B0[2][2], B1[2][2];
    const char* cA = PG8_UA(cur); const char* cB = PG8_UB(cur);
    S.a_ready(cur);
    if constexpr (SP2) {
        PG8_STAGE(PG8_SB(0, 0), cB, voffB); PG8_STAGE(PG8_SB(0, 1), cB + hstepB, voffB); PG8_STAGE(PG8_SA(0, 0), cA, voffA); PG8_STAGE(PG8_SA(0, 1), cA + hstepA, voffA);
        if (wr == 1) PG8_BAR;
        PG8_WAIT_V(2); PG8_BAR;
        PG8_STAGE(PG8_SB(1, 0), cB + kstep, voffB); PG8_STAGE(PG8_SA(1, 0), cA + kstep, voffA); PG8_STAGE(PG8_SB(1, 1), cB + hstepB + kstep, voffB);
        PG8_WAIT_V(6); PG8_BAR;
    } else {
        PG8_STAGE(PG8_SB(0, 0), cB, voffB); PG8_STAGE(PG8_SA(0, 0), cA, voffA); PG8_STAGE(PG8_SB(0, 1), cB + hstepB, voffB); PG8_STAGE(PG8_SA(0, 1), cA + hstepA, voffA);
        if (wr == 1) PG8_BAR;
        PG8_WAIT_V(4); PG8_BAR;
        PG8_STAGE(PG8_SB(1, 0), cB + kstep, voffB); PG8_STAGE(PG8_SA(1, 0), cA + kstep, voffA); PG8_STAGE(PG8_SB(1, 1), cB + hstepB + kstep, voffB);
        PG8_WAIT_V(6); PG8_BAR;
    }
    for (;;) {
        const bool has_next = S.next(ui + 1, nxt);
        const char* nA = has_next ? PG8_UA(nxt) : cA; const char* nB = has_next ? PG8_UB(nxt) : cB;
        for (int t = 0; t < nt; t += 2) {
            const bool last = (t == nt - 2);
            const char* a1 = cA + (size_t)(t + 1) * kstep;
            const char* a2 = last ? nA : cA + (size_t)(t + 2) * kstep; const char* b2 = last ? nB : cB + (size_t)(t + 2) * kstep;
            const char* a3 = a2 + kstep; const char* b3 = b2 + kstep;
            if (last && has_next) S.a_ready(nxt);
            if constexpr (SP2) {
            PG8_LDB(B0, 0, 0); PG8_LDB(B1, 0, 1); PG8_SCHED; PG8_LDA(At, 0, 0); PG8_STAGE(PG8_SA(1, 1), a1 + hstepA, voffA);
            PG8_WAIT_V(8); PG8_WAIT_L(0); PG8_BAR; PG8_MMA(0, 0, At, B0); PG8_MMA(0, 1, At, B1); PG8_BAR; PG8_SCHED;
            PG8_LDA(At, 0, 1); PG8_STAGE(PG8_SB(0, 0), b2, voffB); PG8_STAGE(PG8_SB(0, 1), b2 + hstepB, voffB); PG8_STAGE(PG8_SA(0, 0), a2, voffA);
            PG8_WAIT_V(8); PG8_WAIT_L(0); PG8_BAR; PG8_MMA(1, 0, At, B0); PG8_MMA(1, 1, At, B1); PG8_BAR; PG8_SCHED;
            PG8_LDB(B0, 1, 0); PG8_LDB(B1, 1, 1); PG8_SCHED; PG8_LDA(At, 1, 0); PG8_STAGE(PG8_SA(0, 1), a2 + hstepA, voffA);
            PG8_WAIT_V(8); PG8_WAIT_L(0); PG8_BAR; PG8_MMA(0, 0, At, B0); PG8_MMA(0, 1, At, B1); PG8_BAR; PG8_SCHED;
            PG8_LDA(At, 1, 1); PG8_STAGE(PG8_SB(1, 0), b3, voffB); PG8_STAGE(PG8_SB(1, 1), b3 + hstepB, voffB); PG8_STAGE(PG8_SA(1, 0), a3, voffA);
            PG8_WAIT_V(8); PG8_WAIT_L(0); PG8_BAR; PG8_MMA(1, 0, At, B0); PG8_MMA(1, 1, At, B1); PG8_BAR; PG8_SCHED;
            } else {
            PG8_LDB(B0, 0, 0); PG8_SCHED; PG8_LDA(At, 0, 0); PG8_STAGE(PG8_SA(1, 1), a1 + hstepA, voffA);
            PG8_WAIT_L(8); PG8_BAR; PG8_WAIT_L(0); PG8_MMA(0, 0, At, B0); PG8_BAR; PG8_SCHED;
            PG8_LDB(B1, 0, 1); PG8_STAGE(PG8_SB(0, 0), b2, voffB);
            PG8_BAR; PG8_WAIT_L(0); PG8_MMA(0, 1, At, B1); PG8_BAR;
            PG8_LDA(At, 0, 1); PG8_STAGE(PG8_SA(0, 0), a2, voffA);
            PG8_BAR; PG8_WAIT_L(0); PG8_MMA(1, 0, At, B0); PG8_BAR; PG8_SCHED;
            PG8_STAGE(PG8_SB(0, 1), b2 + hstepB, voffB);
            PG8_WAIT_V(6); PG8_BAR; PG8_MMA(1, 1, At, B1); PG8_BAR;
            PG8_LDB(B0, 1, 0); PG8_SCHED; PG8_LDA(At, 1, 0); PG8_STAGE(PG8_SA(0, 1), a2 + hstepA, voffA);
            PG8_WAIT_L(8); PG8_BAR; PG8_WAIT_L(0); PG8_MMA(0, 0, At, B0); PG8_BAR; PG8_SCHED;
            PG8_LDB(B1, 1, 1); PG8_STAGE(PG8_SB(1, 0), b3, voffB);
            PG8_BAR; PG8_WAIT_L(0); PG8_MMA(0, 1, At, B1); PG8_BAR;
            PG8_LDA(At, 1, 1); PG8_STAGE(PG8_SA(1, 0), a3, voffA);
            PG8_BAR; PG8_WAIT_L(0); PG8_MMA(1, 0, At, B0); PG8_BAR; PG8_SCHED;
            PG8_STAGE(PG8_SB(1, 1), b3 + hstepB, voffB);
            PG8_WAIT_V(6); PG8_BAR; PG8_MMA(1, 1, At, B1); PG8_BAR;
            }
        }
        if constexpr (ALIGN_EPI) { if (wr == 0) PG8_BAR; }
        if constexpr (!Epi::AFTER_DRAIN) { E(acc, cur, wr, wc, fr, fq); S.done(cur); }
        if (!has_next) break;
#pragma unroll
        for (int a = 0; a < 2; ++a)
#pragma unroll
            for (int b = 0; b < 2; ++b)
#pragma unroll
                for (int m = 0; m < 4; ++m)
#pragma unroll
                    for (int n = 0; n < 2; ++n) acc[a][b][m][n] = (f32x4){0.f, 0.f, 0.f, 0.f};
        cur = nxt; cA = nA; cB = nB; ++ui;
        if constexpr (ALIGN_EPI) { if (wr == 1) PG8_BAR; }
    }
    PG8_WAIT_V(0);
    if constexpr (!ALIGN_EPI) { if (wr == 0) PG8_BAR; }
    PG8_BAR;
    if constexpr (Epi::AFTER_DRAIN) { E.fused(acc, cur, wr, wc, fr, fq, lds, wid, lane); S.done(cur); }
#undef PG8_SA
#undef PG8_SB
#undef PG8_STAGE
#undef PG8_LDA
#undef PG8_LDB
#undef PG8_MMA
#undef PG8_WAIT_V
#undef PG8_WAIT_L
#undef PG8_BAR
#undef PG8_SCHED
#undef PG8_UA
#undef PG8_UB
}
}

typedef unsigned short bf16_t;
typedef short bf16x8 __attribute__((ext_vector_type(8)));
typedef short bf16x4 __attribute__((ext_vector_type(4)));
typedef float f32x4 __attribute__((ext_vector_type(4)));
typedef unsigned u32x4 __attribute__((ext_vector_type(4)));
typedef unsigned u32x2 __attribute__((ext_vector_type(2)));
#define LAS __attribute__((address_space(3)))

constexpr int DM = 2048, NB = 2, SEQ = 16384, NMETA = 16, MMAIN = NB * SEQ, MTOK = MMAIN + NB * NMETA, MPAD = 33024;
constexpr int DIN = 14608, DFF = 5632, PW = 8448;
constexpr int C_AQ = 0, C_SZ = 1024, C_HG = 2048, C_AK = 3072, C_AV = 3200, C_XBC = 3328, C_HQ = 5376, C_HF = 6400, C_HI = 7424;
constexpr int NCH = 129;
constexpr float EPS = 1e-6f, NEGV = -1e30f;
constexpr size_t MiB = 1u << 20;
constexpr size_t WS_H = 1 * MiB, WS_U = 259 * MiB, WS_R = 388 * MiB, WS_X = 921 * MiB, WS_NEED = 1024 * MiB;
constexpr size_t DO_WIN = 0, DO_WG = 33 * MiB, DO_WB = 57 * MiB, DO_WO = 69 * MiB, DO_WUP = 77 * MiB, DO_WD = 121 * MiB, DO_WDT = 143 * MiB,
                 DO_HGS = 144 * MiB, DO_HGDEC = 209 * MiB, DO_DTRAW = 211 * MiB, DO_SSDDEC = 214 * MiB,
                 DO_GB = 144 * MiB  , DO_GMETA = 242 * MiB;
constexpr int LDS_BYTES = 163840, NGRID = 256;

__device__ __forceinline__ float bf2f(bf16_t v) { return __builtin_bit_cast(float, (unsigned)v << 16); }
typedef float f32x2_t __attribute__((ext_vector_type(2))); typedef __bf16 bf16x2_t __attribute__((ext_vector_type(2)));
__device__ __forceinline__ unsigned pk2(float lo, float hi) { f32x2_t v = {lo, hi}; bf16x2_t b = __builtin_convertvector(v, bf16x2_t); return __builtin_bit_cast(unsigned, b); }
__device__ __forceinline__ unsigned f2bf(float f) { return pk2(f, 0.f) & 0xffffu; }
__device__ __forceinline__ float bflo(unsigned w) { return __builtin_bit_cast(float, w << 16); }
__device__ __forceinline__ float bfhi(unsigned w) { return __builtin_bit_cast(float, w & 0xffff0000u); }
__device__ __forceinline__ float sigm(float x) { return __builtin_amdgcn_rcpf(1.0f + __expf(-x)); }
__device__ __forceinline__ float siluf(float x) { return x * __builtin_amdgcn_rcpf(1.0f + __expf(-x)); }
__device__ __forceinline__ int tok_row(int b, int t) { return t < NMETA ? (MMAIN + b * NMETA + t) : (b * SEQ + t - NMETA); }
__device__ __forceinline__ float shx(float v, int o, int lane) { return __builtin_bit_cast(float, __builtin_amdgcn_ds_bpermute((lane ^ o) << 2, __builtin_bit_cast(int, v))); }
__device__ __forceinline__ float wave_sum(float v, int lane) {
#pragma unroll
    for (int o = 1; o < 64; o <<= 1) v += shx(v, o, lane);
    return v;
}
__device__ __forceinline__ void unpack8(const u32x4 w, float* f) { f[0] = bflo(w.x); f[1] = bfhi(w.x); f[2] = bflo(w.y); f[3] = bfhi(w.y); f[4] = bflo(w.z); f[5] = bfhi(w.z); f[6] = bflo(w.w); f[7] = bfhi(w.w); }
__device__ __forceinline__ f32x4 mfma32(bf16x8 a, bf16x8 b, f32x4 c) { return __builtin_amdgcn_mfma_f32_16x16x32_bf16(a, b, c, 0, 0, 0); }
__device__ __forceinline__ f32x4 mfma16(bf16x4 a, bf16x4 b, f32x4 c) { return __builtin_amdgcn_mfma_f32_16x16x16bf16_1k(a, b, c, 0, 0, 0); }
__device__ __forceinline__ bf16x4 pack4(f32x4 v) { u32x2 w; w.x = pk2(v[0], v[1]); w.y = pk2(v[2], v[3]); return __builtin_bit_cast(bf16x4, w); }
__device__ __forceinline__ bf16x8 pack8(f32x4 a, f32x4 b) { u32x4 w; w.x = pk2(a[0], a[1]); w.y = pk2(a[2], a[3]); w.z = pk2(b[0], b[1]); w.w = pk2(b[2], b[3]); return __builtin_bit_cast(bf16x8, w); }
__device__ __forceinline__ bf16x8 cat8(u32x2 lo, u32x2 hi) { u32x4 w; w.x = lo.x; w.y = lo.y; w.z = hi.x; w.w = hi.y; return __builtin_bit_cast(bf16x8, w); }

struct Ptrs {
    const float *x, *meta, *rel_bias, *lb_logits, *attn_norm_w, *w_in, *att_sinks, *ssd_conv_w, *ssd_conv_b, *ssd_dt_bias, *ssd_a_log, *ssd_d, *ssd_norm_w,
        *hg_norm_w, *w_branch, *w_out, *ffn_norm_w, *w_up, *ffn_conv_w, *ffn_conv_b, *w_down, *final_norm_w;
    float* out; unsigned char* ws;
};

__device__ __forceinline__ int win_srccol(int r0) {
    return r0 < 1024 ? r0 : r0 < 2048 ? 1280 + (r0 - 1024) : r0 < 3072 ? 7440 + (r0 - 2048) : r0 < 3200 ? 1024 + (r0 - 3072) : r0 < 3328 ? 1152 + (r0 - 3200)
         : r0 < 5376 ? 2304 + (r0 - 3328) : r0 < 6400 ? 4368 + (r0 - 5376) : r0 < 7424 ? 5392 + (r0 - 6400) : 6416 + (r0 - 7424);
}
__device__ __forceinline__ void convert_weights(const Ptrs& P, int l, unsigned char* lds, int gw, int NGW, int lane, int wave) {
    float* scr = (float*)(lds + wave * 16384);
    unsigned char* dob = (unsigned char*)P.out;
    const float* win = P.w_in + (size_t)l * DM * DIN;
#define CONV_DECODE(it) \
            const float* W; bf16_t* WT; int ld, col, K, kb; \
            if (it < 8448) { kb = it & 31; const int r0 = 32 * (it >> 5); W = win; ld = DIN; col = win_srccol(r0); K = DM; WT = (bf16_t*)(dob + DO_WIN) + (size_t)r0 * DM; } \
            else if (it < 14592) { const int i2 = it - 8448; kb = i2 & 31; const int r0 = 32 * (i2 >> 5); W = win; ld = DIN; col = 8464 + r0; K = DM; WT = (bf16_t*)(dob + DO_WG) + (size_t)r0 * DM; } \
            else if (it < 17664) { const int i2 = it - 14592, n = i2 >> 10, i3 = i2 & 1023; kb = i3 & 15; const int r0 = 32 * (i3 >> 4); W = P.w_branch + ((size_t)l * 3 + n) * 1024 * DM; ld = DM; col = r0; K = 1024; \
                WT = (bf16_t*)(dob + DO_WB) + (size_t)n * DM * 1024 + (size_t)r0 * 1024; } \
            else if (it < 19712) { const int i2 = it - 17664; kb = i2 & 31; const int r0 = 32 * (i2 >> 5); W = P.w_out + (size_t)l * DM * DM; ld = DM; col = r0; K = DM; WT = (bf16_t*)(dob + DO_WO) + (size_t)r0 * DM; } \
            else if (it < 30976) { const int i2 = it - 19712; kb = i2 & 31; const int r0 = 32 * (i2 >> 5); W = P.w_up + (size_t)l * DM * 2 * DFF; ld = 2 * DFF; col = r0; K = DM; WT = (bf16_t*)(dob + DO_WUP) + (size_t)r0 * DM; } \
            else { const int i2 = it - 30976; kb = i2 % 88; const int r0 = 32 * (i2 / 88); W = P.w_down + (size_t)l * DFF * DM; ld = DM; col = r0; K = DFF; WT = (bf16_t*)(dob + DO_WD) + (size_t)r0 * DFF; } \
        const int k0 = 64 * kb;
#define CONV_LOAD(dst) do { _Pragma("unroll") for (int i = 0; i < 32; ++i) { const int kk = 2 * i + (lane >> 5); dst[i] = W[(size_t)(k0 + kk) * ld + col + (lane & 31)]; } } while (0)
    float wn_[32];
    if (gw < 36608) { const int it = gw; CONV_DECODE(it) CONV_LOAD(wn_); }
    for (int it = gw; it < 36608; it += NGW) {
        bf16_t* WTc; int Kc, k0c;
        { CONV_DECODE(it) WTc = WT; Kc = K; k0c = k0; (void)W; (void)ld; (void)col; }
        float wv_[32];
#pragma unroll
        for (int i = 0; i < 32; ++i) wv_[i] = wn_[i];
        if (it + NGW < 36608) { const int it2 = it + NGW; CONV_DECODE(it2) CONV_LOAD(wn_); }
#pragma unroll
        for (int i = 0; i < 32; ++i) { const int kk = 2 * i + (lane >> 5); scr[kk * 33 + (lane & 31)] = wv_[i]; }
        asm volatile("s_waitcnt lgkmcnt(0)" ::: "memory");
        const int cc = lane & 7;
#pragma unroll
        for (int j = 0; j < 4; ++j) { const int n = (lane >> 3) + 8 * j; const float* s = scr + (8 * cc) * 33 + n;
            u32x4 o; o.x = pk2(s[0 * 33], s[1 * 33]); o.y = pk2(s[2 * 33], s[3 * 33]); o.z = pk2(s[4 * 33], s[5 * 33]); o.w = pk2(s[6 * 33], s[7 * 33]);
            pg8::store16_wt(WTc + (size_t)n * Kc + k0c + 8 * cc, o); }
        asm volatile("s_waitcnt lgkmcnt(0)" ::: "memory");
    }
#undef CONV_DECODE
#undef CONV_LOAD
    bf16_t* WdtT = (bf16_t*)(dob + DO_WDT);
    for (int idx = gw * 64 + lane; idx < 16 * DM; idx += NGW * 64) { const int j = idx >> 11, k = idx & 2047; WdtT[idx] = (bf16_t)f2bf(win[(size_t)k * DIN + 4352 + j]); }
}

template <int MODE> __device__ __forceinline__ void norm_phase(const Ptrs& P, const float* nw, int gw, int NGW, int lane) {
    bf16_t* H = (bf16_t*)(P.ws + WS_H); bf16_t* U = (bf16_t*)(P.ws + WS_U);
    const int nrows = (MODE == 2) ? MMAIN : MTOK;
    f32x4 xn[8]; u32x2 hn[8];
#define NORM_LOAD(r_) do { const int rr_ = (r_); if (MODE == 1) { const float* src = (rr_ < MMAIN) ? (P.x + (size_t)rr_ * DM) : (P.meta + (size_t)((rr_ - MMAIN) & 15) * DM); \
        _Pragma("unroll") for (int j = 0; j < 8; ++j) xn[j] = ((const f32x4*)src)[64 * j + lane]; } \
      else { _Pragma("unroll") for (int j = 0; j < 8; ++j) hn[j] = ((const u32x2*)(H + (size_t)rr_ * DM))[64 * j + lane]; } } while (0)
    int row = gw;
    if (row < nrows) NORM_LOAD(row);
    for (; row < nrows; row += NGW) {
        f32x4 v[8]; float ss = 0.f;
#pragma unroll
        for (int j = 0; j < 8; ++j) v[j] = (MODE == 1) ? xn[j] : (f32x4){bflo(hn[j].x), bfhi(hn[j].x), bflo(hn[j].y), bfhi(hn[j].y)};
        if (row + NGW < nrows) NORM_LOAD(row + NGW);
#pragma unroll
        for (int j = 0; j < 8; ++j) ss += (v[j][0] * v[j][0] + v[j][1] * v[j][1]) + (v[j][2] * v[j][2] + v[j][3] * v[j][3]);
        ss = wave_sum(ss, lane);
        const float rstd = 1.0f / sqrtf(ss * (1.0f / DM) + EPS);
        if (MODE == 1) {
#pragma unroll
            for (int j = 0; j < 8; ++j) { u32x2 w; w.x = pk2(v[j][0], v[j][1]); w.y = pk2(v[j][2], v[j][3]); pg8::store8_wt((u32x2*)(H + (size_t)row * DM) + 64 * j + lane, w); }
        }
#pragma unroll
        for (int j = 0; j < 8; ++j) {
            const f32x4 w4 = ((const f32x4*)nw)[64 * j + lane];
            const f32x4 o = v[j] * rstd * w4;
            if (MODE == 2) ((f32x4*)(P.out + (size_t)row * DM))[64 * j + lane] = o;
            else { u32x2 w; w.x = pk2(o[0], o[1]); w.y = pk2(o[2], o[3]); pg8::store8_wt((u32x2*)(U + (size_t)row * DM) + 64 * j + lane, w); }
        }
    }
#undef NORM_LOAD
}

__device__ __forceinline__ void dt_phase(const Ptrs& P, int gw, int NGW, int lane) {
    const bf16_t* U = (const bf16_t*)(P.ws + WS_U); const bf16_t* WdtT = (const bf16_t*)((unsigned char*)P.out + DO_WDT); float* dtraw = (float*)((unsigned char*)P.out + DO_DTRAW);
    const int lc = lane & 15, g = lane >> 4;
    for (int it = gw; it < MTOK / 16; it += NGW) {
        const int r0 = 16 * it; f32x4 acc = {0.f, 0.f, 0.f, 0.f};
        const bf16_t* ap = U + (size_t)(r0 + lc) * DM + 8 * g; const bf16_t* bp = WdtT + (size_t)lc * DM + 8 * g;
#pragma unroll 8
        for (int ks = 0; ks < 64; ++ks) { const bf16x8 a = *(const bf16x8*)(ap + ks * 32); const bf16x8 b = *(const bf16x8*)(bp + ks * 32); acc = mfma32(a, b, acc); }
#pragma unroll
        for (int r = 0; r < 4; ++r) dtraw[(size_t)(r0 + 4 * g + r) * 16 + lc] = acc[r];
    }
}

constexpr int AT_KS = 0, AT_VT = 36864, AT_KM = 72704, AT_HB = 75008, AT_BKT = 159744, AT_RB = 160256;
__device__ __forceinline__ void attn_tables(const Ptrs& P, unsigned char* lds, int tid) {
    int* bkt = (int*)(lds + AT_BKT); float* rb = (float*)(lds + AT_RB);
    if (tid < 128) { int bk; if (tid < 16) bk = tid; else { const float nf = (float)tid; int lg = 16 + (int)(logf(nf / 16.0f) / 2.0794415416798357f * 16.0f); bk = lg < 31 ? lg : 31; } bkt[tid] = bk; }
    rb[tid] = P.rel_bias[tid];
}
__device__ __forceinline__ void attn_unit(const Ptrs& P, int l, int b, int gk, int n, unsigned char* lds, int tid, bool dost) {
    bf16_t* PJ = (bf16_t*)(P.ws + WS_R);
    const int lane = tid & 63, w = tid >> 6, lc = lane & 15, g = lane >> 4;
    bf16_t* Vt = (bf16_t*)(lds + AT_VT); const int* bkt = (const int*)(lds + AT_BKT); const float* rb = (const float*)(lds + AT_RB); float* hb = (float*)(lds + AT_HB);
    {
        const int key = tid >> 1, half = tid & 1; const bool valid = (n >= 2) || (n == 1 && key >= 128);
        u32x4 kv[4], vv[4];
        if (valid) { const bf16_t* rp = PJ + (size_t)(b * SEQ + (n - 2) * 128 + key) * PW + gk * 64 + half * 32;
#pragma unroll
            for (int i = 0; i < 4; ++i) { kv[i] = *(const u32x4*)(rp + C_AK + 8 * i); vv[i] = *(const u32x4*)(rp + C_AV + 8 * i); } }
        else {
#pragma unroll
            for (int i = 0; i < 4; ++i) { kv[i] = (u32x4){0u, 0u, 0u, 0u}; vv[i] = (u32x4){0u, 0u, 0u, 0u}; } }
#pragma unroll
        for (int i = 0; i < 4; ++i) {
            *(u32x4*)(lds + AT_KS + key * 144 + half * 64 + i * 16) = kv[i];
            const int d0 = half * 32 + i * 8;
            Vt[(d0 + 0) * 280 + key] = (bf16_t)(vv[i].x & 0xffffu); Vt[(d0 + 1) * 280 + key] = (bf16_t)(vv[i].x >> 16);
            Vt[(d0 + 2) * 280 + key] = (bf16_t)(vv[i].y & 0xffffu); Vt[(d0 + 3) * 280 + key] = (bf16_t)(vv[i].y >> 16);
            Vt[(d0 + 4) * 280 + key] = (bf16_t)(vv[i].z & 0xffffu); Vt[(d0 + 5) * 280 + key] = (bf16_t)(vv[i].z >> 16);
            Vt[(d0 + 6) * 280 + key] = (bf16_t)(vv[i].w & 0xffffu); Vt[(d0 + 7) * 280 + key] = (bf16_t)(vv[i].w >> 16);
        }
    }
    if (tid < 32) {
        const int m = tid >> 1, half = tid & 1; const bf16_t* rp = PJ + (size_t)(MMAIN + b * NMETA + m) * PW + gk * 64 + half * 32;
#pragma unroll
        for (int i = 0; i < 4; ++i) { const u32x4 kvv = *(const u32x4*)(rp + C_AK + 8 * i); const u32x4 vvv = *(const u32x4*)(rp + C_AV + 8 * i);
            *(u32x4*)(lds + AT_KM + m * 144 + half * 64 + i * 16) = kvv;
            const int d0 = half * 32 + i * 8;
            Vt[(d0 + 0) * 280 + 256 + m] = (bf16_t)(vvv.x & 0xffffu); Vt[(d0 + 1) * 280 + 256 + m] = (bf16_t)(vvv.x >> 16);
            Vt[(d0 + 2) * 280 + 256 + m] = (bf16_t)(vvv.y & 0xffffu); Vt[(d0 + 3) * 280 + 256 + m] = (bf16_t)(vvv.y >> 16);
            Vt[(d0 + 4) * 280 + 256 + m] = (bf16_t)(vvv.z & 0xffffu); Vt[(d0 + 5) * 280 + 256 + m] = (bf16_t)(vvv.z >> 16);
            Vt[(d0 + 6) * 280 + 256 + m] = (bf16_t)(vvv.w & 0xffffu); Vt[(d0 + 7) * 280 + 256 + m] = (bf16_t)(vvv.w >> 16); }
    }
    const int head = gk * 8 + w;
    hb[w * 128 + lane] = rb[bkt[lane] * 16 + head]; hb[w * 128 + 64 + lane] = rb[bkt[64 + lane] * 16 + head];
    __syncthreads();
    const float sink = P.att_sinks[l * 16 + head];
    const int qs0 = (n == 0) ? 7 : 0;
    bf16x8 qn0, qn1;
    { const bf16_t* qp = PJ + (size_t)tok_row(b, n * 128 + 16 * qs0 + lc - 112) * PW + C_AQ + head * 64; qn0 = *(const bf16x8*)(qp + 8 * g); qn1 = *(const bf16x8*)(qp + 32 + 8 * g); }
#pragma unroll 1
    for (int qs = qs0; qs < 8; ++qs) {
        const int tq = n * 128 + 16 * qs + lc - 112;
        const size_t qrow = (size_t)tok_row(b, tq);
        bf16_t* qp = PJ + qrow * PW + C_AQ + head * 64;
        const bf16x8 q0 = qn0, q1 = qn1;
        if (qs + 1 < 8) { const bf16_t* qp2 = PJ + (size_t)tok_row(b, tq + 16) * PW + C_AQ + head * 64; qn0 = *(const bf16x8*)(qp2 + 8 * g); qn1 = *(const bf16x8*)(qp2 + 32 + 8 * g); }
        f32x4 st[10];
#pragma unroll
        for (int kt = 0; kt < 9; ++kt) { const unsigned char* kp = lds + AT_KS + (16 * (qs + kt) + lc) * 144 + 16 * g;
            const bf16x8 a0 = *(const bf16x8*)kp, a1 = *(const bf16x8*)(kp + 64);
            f32x4 z = {0.f, 0.f, 0.f, 0.f}; z = mfma32(a0, q0, z); st[kt] = mfma32(a1, q1, z); }
        { const unsigned char* kp = lds + AT_KM + lc * 144 + 16 * g; const bf16x8 a0 = *(const bf16x8*)kp, a1 = *(const bf16x8*)(kp + 64);
            f32x4 z = {0.f, 0.f, 0.f, 0.f}; z = mfma32(a0, q0, z); st[9] = mfma32(a1, q1, z); }
        float mx = sink;
#pragma unroll
        for (int kt = 0; kt < 9; ++kt)
#pragma unroll
            for (int r = 0; r < 4; ++r) { const int dist = 128 + lc - 16 * kt - 4 * g - r; const int j = 16 * (qs + kt) + 4 * g + r;
                const bool valid = (dist >= 0) && (dist < 128) && (n >= 1) && (n >= 2 || j >= 128);
                const float lg = valid ? (st[kt][r] * 0.125f + hb[w * 128 + (dist & 127)]) : NEGV; st[kt][r] = lg; mx = fmaxf(mx, lg); }
#pragma unroll
        for (int r = 0; r < 4; ++r) { const int dist = tq - (4 * g + r); const bool valid = dist >= 0; const int bk = (dist >= 0 && dist < 128) ? bkt[dist & 127] : 31;
            const float lg = valid ? (st[9][r] * 0.125f + rb[bk * 16 + head]) : NEGV; st[9][r] = lg; mx = fmaxf(mx, lg); }
        mx = fmaxf(mx, shx(mx, 16, lane)); mx = fmaxf(mx, shx(mx, 32, lane));
        float sum = 0.f;
#pragma unroll
        for (int kt = 0; kt < 10; ++kt)
#pragma unroll
            for (int r = 0; r < 4; ++r) { const float p = __expf(st[kt][r] - mx); st[kt][r] = p; sum += p; }
        sum += shx(sum, 16, lane); sum += shx(sum, 32, lane);
        const float inv = 1.0f / (sum + __expf(sink - mx));
        f32x4 o[4];
#pragma unroll
        for (int dt = 0; dt < 4; ++dt) o[dt] = (f32x4){0.f, 0.f, 0.f, 0.f};
#pragma unroll
        for (int j = 0; j < 5; ++j) {
            const bf16x8 pb = pack8(st[2 * j], st[2 * j + 1]);
            const int colA = 16 * (qs + 2 * j) + 4 * g; const int colB = (j < 4) ? (16 * (qs + 2 * j + 1) + 4 * g) : (256 + 4 * g);
#pragma unroll
            for (int dt = 0; dt < 4; ++dt) { const int d = 16 * dt + lc;
                const u32x2 lo = *(const u32x2*)(Vt + d * 280 + colA), hi = *(const u32x2*)(Vt + d * 280 + colB);
                o[dt] = mfma32(cat8(lo, hi), pb, o[dt]); }
        }
#pragma unroll
        for (int dt = 0; dt < 4; ++dt) { u32x2 wv; wv.x = pk2(o[dt][0] * inv, o[dt][1] * inv); wv.y = pk2(o[dt][2] * inv, o[dt][3] * inv); if (dost) *(u32x2*)(qp + 16 * dt + 4 * g) = wv; }
    }
    __syncthreads();
}

constexpr int SD_XT = 0, SD_BS = 69632, SD_CS = 104448, SD_ACS = 139264, SD_DTS = 141312, SD_SSQ = 143360, SD_WS = 145408;
__device__ __forceinline__ int sdz(int row, int col) { return row * 136 + (col ^ (((row >> 3) & 15) << 3)); }
template <bool PASSA> __device__ __forceinline__ void ssd_stage(const Ptrs& P, int l, int b, int ch, int gg, unsigned char* lds, int tid) {
    const bf16_t* PJ = (const bf16_t*)(P.ws + WS_R);
    const int lane = tid & 63, seg = tid >> 6, l0 = 16 * seg, nvalid = (ch == 0) ? 16 : 128;
    bf16_t* Xt = (bf16_t*)(lds + SD_XT); bf16_t* Bs = (bf16_t*)(lds + SD_BS); bf16_t* Cs = (bf16_t*)(lds + SD_CS);
    int kind, xcol, i0;
    if (lane < 32) { kind = 0; i0 = 8 * lane; xcol = gg * 256 + i0; }
    else if (lane < 48) { kind = 1; i0 = 8 * (lane - 32); xcol = 1024 + gg * 128 + i0; }
    else { kind = 2; i0 = 8 * (lane - 48); xcol = 1536 + gg * 128 + i0; }
    if (!(PASSA && kind == 2)) {
        float wgt[4][8], bias[8];
        const float* cw = P.ssd_conv_w + (size_t)l * 4 * 2048 + xcol; const float* cb = P.ssd_conv_b + (size_t)l * 2048 + xcol;
#pragma unroll
        for (int k = 0; k < 4; ++k) { const f32x4 a = *(const f32x4*)(cw + k * 2048), c2 = *(const f32x4*)(cw + k * 2048 + 4);
            wgt[k][0] = a[0]; wgt[k][1] = a[1]; wgt[k][2] = a[2]; wgt[k][3] = a[3]; wgt[k][4] = c2[0]; wgt[k][5] = c2[1]; wgt[k][6] = c2[2]; wgt[k][7] = c2[3]; }
        { const f32x4 a = *(const f32x4*)cb, c2 = *(const f32x4*)(cb + 4); bias[0] = a[0]; bias[1] = a[1]; bias[2] = a[2]; bias[3] = a[3]; bias[4] = c2[0]; bias[5] = c2[1]; bias[6] = c2[2]; bias[7] = c2[3]; }
        const int t0 = (ch == 0) ? l0 : (NMETA + 128 * (ch - 1) + l0);
        float x0[8], x1[8], x2[8], x3[8];
        const bool live = l0 < nvalid;
#define SSD_LDX(dst, tt) do { const int t_ = (tt); if (live && t_ >= 0) { const u32x4 w_ = *(const u32x4*)(PJ + (size_t)tok_row(b, t_) * PW + C_XBC + xcol); unpack8(w_, dst); } \
            else { _Pragma("unroll") for (int e_ = 0; e_ < 8; ++e_) dst[e_] = 0.f; } } while (0)
#define SSD_LD(tt) ((live && (tt) >= 0) ? *(const u32x4*)(PJ + (size_t)tok_row(b, (tt)) * PW + C_XBC + xcol) : (u32x4){0u, 0u, 0u, 0u})
        { const u32x4 h0 = SSD_LD(t0 - 3), h1 = SSD_LD(t0 - 2), h2 = SSD_LD(t0 - 1); unpack8(h0, x0); unpack8(h1, x1); unpack8(h2, x2); }
        u32x4 n0 = SSD_LD(t0), n1 = SSD_LD(t0 + 1), n2 = SSD_LD(t0 + 2), n3 = SSD_LD(t0 + 3);
#pragma unroll 1
        for (int i = 0; i < 16; ++i) {
            const int li = l0 + i;
            unpack8(n0, x3); n0 = n1; n1 = n2; n2 = n3; n3 = (i + 4 < 16) ? SSD_LD(t0 + i + 4) : (u32x4){0u, 0u, 0u, 0u};
            float o[8];
#pragma unroll
            for (int e = 0; e < 8; ++e) { float v = bias[e] + wgt[0][e] * x0[e] + wgt[1][e] * x1[e] + wgt[2][e] * x2[e] + wgt[3][e] * x3[e]; v = siluf(v); o[e] = (li < nvalid) ? v : 0.f;
                x0[e] = x1[e]; x1[e] = x2[e]; x2[e] = x3[e]; }
            if (kind == 0) {
#pragma unroll
                for (int e = 0; e < 8; ++e) Xt[sdz(i0 + e, li)] = (bf16_t)f2bf(o[e]);
            } else if (kind == 1) {
                if (PASSA) {
#pragma unroll
                    for (int e = 0; e < 8; ++e) Bs[sdz(i0 + e, li)] = (bf16_t)f2bf(o[e]);
                } else { u32x4 wv; wv.x = pk2(o[0], o[1]); wv.y = pk2(o[2], o[3]); wv.z = pk2(o[4], o[5]); wv.w = pk2(o[6], o[7]); *(u32x4*)(Bs + li * 136 + i0) = wv; }
            } else { u32x4 wv; wv.x = pk2(o[0], o[1]); wv.y = pk2(o[2], o[3]); wv.z = pk2(o[4], o[5]); wv.w = pk2(o[6], o[7]); *(u32x4*)(Cs + li * 136 + i0) = wv; }
        }
#undef SSD_LD
#undef SSD_LDX
    }
    float* ACS = (float*)(lds + SD_ACS); float* DTS = (float*)(lds + SD_DTS);
    { const int hh = tid >> 7, li = tid & 127; const int h = gg * 4 + hh; float dt = 0.f, dA = 0.f;
      if (li < nvalid) { const int row = (ch == 0) ? (MMAIN + b * NMETA + li) : (b * SEQ + 128 * (ch - 1) + li);
          const float* dtraw = (const float*)((const unsigned char*)P.out + DO_DTRAW);
          const float raw = dtraw[(size_t)row * 16 + h] + P.ssd_dt_bias[l * 16 + h];
          dt = raw > 20.f ? raw : log1pf(__expf(raw)); dA = -dt * __expf(P.ssd_a_log[l * 16 + h]); }
      DTS[hh * 128 + li] = dt; ACS[hh * 128 + li] = dA; }
    __syncthreads();
    if (seg < 4) { const int hh = seg; const float v0 = ACS[hh * 128 + 2 * lane], v1 = ACS[hh * 128 + 2 * lane + 1]; const float s = v0 + v1; float sc = s;
#pragma unroll
        for (int o = 1; o < 64; o <<= 1) { const float t = __builtin_bit_cast(float, __builtin_amdgcn_ds_bpermute(((lane - o) & 63) << 2, __builtin_bit_cast(int, sc))); if (lane >= o) sc += t; }
        const float ex = sc - s; ACS[hh * 128 + 2 * lane] = ex + v0; ACS[hh * 128 + 2 * lane + 1] = ex + v0 + v1; }
    __syncthreads();
}

__device__ __forceinline__ void ssd_passA(const Ptrs& P, int l, int b, int ch, int gg, unsigned char* lds, int tid) {
    ssd_stage<true>(P, l, b, ch, gg, lds, tid);
    const int lane = tid & 63, w = tid >> 6, lc = lane & 15, g = lane >> 4, hh = w & 3, half = w >> 2, h = gg * 4 + hh;
    const float* ACS = (const float*)(lds + SD_ACS); const float* DTS = (const float*)(lds + SD_DTS); float* WSg = (float*)(lds + SD_WS);
    const bf16_t* Xt = (const bf16_t*)(lds + SD_XT); const bf16_t* Bt = (const bf16_t*)(lds + SD_BS);
    { const int h2 = tid >> 7, s = tid & 127; WSg[h2 * 128 + s] = __expf(ACS[h2 * 128 + 127] - ACS[h2 * 128 + s]) * DTS[h2 * 128 + s]; }
    __syncthreads();
    bf16x8 af[4][4];
#pragma unroll
    for (int pt = 0; pt < 4; ++pt)
#pragma unroll
        for (int ks = 0; ks < 4; ++ks) { const u32x4 raw = *(const u32x4*)(Xt + sdz(hh * 64 + 16 * pt + lc, 32 * ks + 8 * g)); float f[8]; unpack8(raw, f);
            const float* wp = WSg + hh * 128 + 32 * ks + 8 * g;
            u32x4 o; o.x = pk2(f[0] * wp[0], f[1] * wp[1]); o.y = pk2(f[2] * wp[2], f[3] * wp[3]); o.z = pk2(f[4] * wp[4], f[5] * wp[5]); o.w = pk2(f[6] * wp[6], f[7] * wp[7]);
            af[pt][ks] = __builtin_bit_cast(bf16x8, o); }
    bf16_t* ST = (bf16_t*)(P.ws + WS_X) + (size_t)((b * NCH + ch) * 16 + h) * 8192;
#pragma unroll 1
    for (int nt = 4 * half; nt < 4 * half + 4; ++nt) {
        f32x4 st[4];
#pragma unroll
        for (int pt = 0; pt < 4; ++pt) st[pt] = (f32x4){0.f, 0.f, 0.f, 0.f};
#pragma unroll
        for (int ks = 0; ks < 4; ++ks) { const bf16x8 bfr = *(const bf16x8*)(Bt + sdz(16 * nt + lc, 32 * ks + 8 * g));
#pragma unroll
            for (int pt = 0; pt < 4; ++pt) st[pt] = mfma32(af[pt][ks], bfr, st[pt]); }
#pragma unroll
        for (int pt = 0; pt < 4; ++pt)
#pragma unroll
            for (int r = 0; r < 4; ++r) ST[(16 * pt + 4 * g + r) * 128 + 16 * nt + lc] = (bf16_t)f2bf(st[pt][r]);
    }
    if (tid < 4) { float* dec = (float*)((unsigned char*)P.out + DO_SSDDEC); dec[(b * NCH + ch) * 16 + gg * 4 + tid] = __expf(ACS[tid * 128 + 127]); }
    __syncthreads();
}

__device__ __forceinline__ void ssd_passB(const Ptrs& P, int l, int b, int ch, int gg, unsigned char* lds, int tid, bool dost) {
    ssd_stage<false>(P, l, b, ch, gg, lds, tid);
    bf16_t* PJ = (bf16_t*)(P.ws + WS_R);
    const int lane = tid & 63, w = tid >> 6, lc = lane & 15, g = lane >> 4, hh = w & 3, half = w >> 2, h = gg * 4 + hh;
    const float* ACS = (const float*)(lds + SD_ACS) + hh * 128; const float* DTS = (const float*)(lds + SD_DTS) + hh * 128; float* SSQ = (float*)(lds + SD_SSQ);
    const bf16_t* Xt = (const bf16_t*)(lds + SD_XT); const bf16_t* Bs = (const bf16_t*)(lds + SD_BS); const bf16_t* Cs = (const bf16_t*)(lds + SD_CS);
    const bf16_t* ST = (const bf16_t*)(P.ws + WS_X) + (size_t)((b * NCH + ch) * 16 + h) * 8192;
    const int nlt = (ch == 0) ? (half == 0 ? 1 : 0) : 4;
    const float dsk = P.ssd_d[l * 16 + h];
    bf16x8 sf[4][4];
#pragma unroll
    for (int pt = 0; pt < 4; ++pt)
#pragma unroll
        for (int ks = 0; ks < 4; ++ks) sf[pt][ks] = *(const bf16x8*)(ST + (16 * pt + lc) * 128 + 32 * ks + 8 * g);
    u32x2 zwv[4][4];
#pragma unroll
    for (int lti = 0; lti < 4; ++lti) {
        const int lt = (lti == 0) ? half : (lti == 1) ? 3 - half : (lti == 2) ? 4 + half : 7 - half, li = 16 * lt + lc;
        const bool rv = (lti < nlt) && ((ch != 0) || (li < 16));
        const size_t row = (ch == 0) ? (size_t)(MMAIN + b * NMETA + (li & 15)) : (size_t)(b * SEQ + 128 * (ch - 1) + li);
#pragma unroll
        for (int pt = 0; pt < 4; ++pt) { zwv[lti][pt] = (u32x2){0u, 0u}; if (rv) zwv[lti][pt] = *(const u32x2*)(PJ + row * PW + C_SZ + h * 64 + 16 * pt + 4 * g); } }
    f32x4 gz[4][4];
#pragma unroll
    for (int lti = 0; lti < 4; ++lti) {
#pragma unroll
        for (int pt = 0; pt < 4; ++pt) gz[lti][pt] = (f32x4){0.f, 0.f, 0.f, 0.f};
        if (lti < nlt) {
            const int lt = (lti == 0) ? half : (lti == 1) ? 3 - half : (lti == 2) ? 4 + half : 7 - half, li = 16 * lt + lc; const float Al = ACS[li];
            bf16x8 cf[4];
#pragma unroll
            for (int ks = 0; ks < 4; ++ks) cf[ks] = *(const bf16x8*)(Cs + li * 136 + 32 * ks + 8 * g);
            f32x4 o[4];
#pragma unroll
            for (int pt = 0; pt < 4; ++pt) { f32x4 z = {0.f, 0.f, 0.f, 0.f};
#pragma unroll
                for (int ks = 0; ks < 4; ++ks) z = mfma32(sf[pt][ks], cf[ks], z);
                const float eA = __expf(Al); o[pt] = z * eA; }
            for (int j = 0; j <= (lt >> 1); ++j) {
                f32x4 cb0 = {0.f, 0.f, 0.f, 0.f}, cb1 = {0.f, 0.f, 0.f, 0.f};
#pragma unroll
                for (int ks = 0; ks < 4; ++ks) { const bf16x8 a0 = *(const bf16x8*)(Bs + (32 * j + lc) * 136 + 32 * ks + 8 * g), a1 = *(const bf16x8*)(Bs + (32 * j + 16 + lc) * 136 + 32 * ks + 8 * g);
                    cb0 = mfma32(a0, cf[ks], cb0); cb1 = mfma32(a1, cf[ks], cb1); }
#pragma unroll
                for (int r = 0; r < 4; ++r) { const int s0 = 32 * j + 4 * g + r, s1 = s0 + 16;
                    cb0[r] = (s0 <= li) ? cb0[r] * __expf(Al - ACS[s0]) * DTS[s0] : 0.f;
                    cb1[r] = (s1 <= li) ? cb1[r] * __expf(Al - ACS[s1]) * DTS[s1] : 0.f; }
                const bf16x8 pb = pack8(cb0, cb1);
#pragma unroll
                for (int pt = 0; pt < 4; ++pt) { const int xr = hh * 64 + 16 * pt + lc;
                    const u32x2 lo = *(const u32x2*)(Xt + sdz(xr, 32 * j + 4 * g)), hi = *(const u32x2*)(Xt + sdz(xr, 32 * j + 16 + 4 * g)); o[pt] = mfma32(cat8(lo, hi), pb, o[pt]); }
            }
            const bool rv = (ch != 0) || (li < 16);
            const size_t row = (ch == 0) ? (size_t)(MMAIN + b * NMETA + (li & 15)) : (size_t)(b * SEQ + 128 * (ch - 1) + li);
            float part = 0.f;
#pragma unroll
            for (int pt = 0; pt < 4; ++pt) { const u32x2 zw = zwv[lti][pt];
                const float zf[4] = {bflo(zw.x), bfhi(zw.x), bflo(zw.y), bfhi(zw.y)};
#pragma unroll
                for (int r = 0; r < 4; ++r) { const float xs = bf2f(Xt[sdz(hh * 64 + 16 * pt + 4 * g + r, li)]); const float y = o[pt][r] + xs * dsk; const float v = y * siluf(zf[r]); gz[lti][pt][r] = v; part += v * v; } }
            part += shx(part, 16, lane); part += shx(part, 32, lane);
            if (g == 0) SSQ[li * 4 + hh] = part;
        }
    }
    f32x4 nwv[4];
#pragma unroll
    for (int pt = 0; pt < 4; ++pt) nwv[pt] = *(const f32x4*)(P.ssd_norm_w + l * 1024 + h * 64 + 16 * pt + 4 * g);
    __syncthreads();
#pragma unroll
    for (int lti = 0; lti < 4; ++lti) {
        if (lti < nlt) {
            const int lt = (lti == 0) ? half : (lti == 1) ? 3 - half : (lti == 2) ? 4 + half : 7 - half, li = 16 * lt + lc;
            const bool rv = (ch != 0) || (li < 16);
            const size_t row = (ch == 0) ? (size_t)(MMAIN + b * NMETA + (li & 15)) : (size_t)(b * SEQ + 128 * (ch - 1) + li);
            const float tot = (SSQ[li * 4 + 0] + SSQ[li * 4 + 1]) + (SSQ[li * 4 + 2] + SSQ[li * 4 + 3]);
            const float rstd = 1.0f / sqrtf(tot * (1.0f / 256.0f) + EPS);
            if (rv && dost) {
#pragma unroll
                for (int pt = 0; pt < 4; ++pt) { const f32x4 nw = nwv[pt];
                    u32x2 wv; wv.x = pk2(gz[lti][pt][0] * rstd * nw[0], gz[lti][pt][1] * rstd * nw[1]); wv.y = pk2(gz[lti][pt][2] * rstd * nw[2], gz[lti][pt][3] * rstd * nw[3]);
                    *(u32x2*)(PJ + row * PW + C_SZ + h * 64 + 16 * pt + 4 * g) = wv; }
            }
        }
    }
    __syncthreads();
}

constexpr int HG_QB = 0, HG_KB = 34816, HG_KET = 69632, HG_EBE = 110592, HG_VT = 114688, HG_SSQ = 155648;
__device__ __forceinline__ void hg_unit(const Ptrs& P, int l, int b, int hd, int ch, unsigned char* lds, int tid) {
    bf16_t* PJ = (bf16_t*)(P.ws + WS_R);
    const int lane = tid & 63, w = tid >> 6, lc = lane & 15, g = lane >> 4;
    const int nsub = (ch == 0) ? 1 : 8;
    const size_t row0 = (ch == 0) ? (size_t)(MMAIN + b * NMETA) : (size_t)(b * SEQ + 128 * (ch - 1));
    bf16_t* Qb = (bf16_t*)(lds + HG_QB); bf16_t* Kb = (bf16_t*)(lds + HG_KB); bf16_t* Ket = (bf16_t*)(lds + HG_KET); float* EBE = (float*)(lds + HG_EBE);
    bf16_t* Vt = (bf16_t*)(lds + HG_VT) + w * 8 * 16 * 20; float* DT = (float*)(lds + HG_SSQ);
    bf16_t* HS = (bf16_t*)((unsigned char*)P.out + DO_HGS) + (size_t)((b * 8 + hd) * NCH + ch) * 16384;
    u32x2 vv[8];
    { const int t = lane >> 2, v4 = (lane & 3) * 4;
#pragma unroll
      for (int j = 0; j < 8; ++j) { vv[j] = (u32x2){0u, 0u}; if (j < nsub) vv[j] = *(const u32x2*)(PJ + (row0 + 16 * j + t) * PW + C_HI + hd * 128 + 16 * w + v4); } }
    {
        const int dk = tid & 127, sg = tid >> 7;
        float lb = 0.f;
        if (l == 1) { const float a0 = P.lb_logits[hd * 128 + dk], a1 = P.lb_logits[1024 + hd * 128 + dk]; const float mxx = fmaxf(a0, a1); const float e0 = __expf(a0 - mxx), e1 = __expf(a1 - mxx);
            lb = e1 / (e0 + e1); lb = fminf(fmaxf(lb, 0.f), 1.0f - 1e-4f); }
        bf16_t hfv[2][16], hqv[2][16];
#pragma unroll
        for (int jj = 0; jj < 2; ++jj) { const int j = 2 * sg + jj;
#pragma unroll
            for (int t = 0; t < 16; ++t) { hfv[jj][t] = 0; hqv[jj][t] = 0;
                if (j < nsub) { const bf16_t* rp = PJ + (row0 + 16 * j + t) * PW + hd * 128 + dk; hfv[jj][t] = rp[C_HF]; hqv[jj][t] = rp[C_HQ]; } } }
#pragma unroll
        for (int jj = 0; jj < 2; ++jj) { const int j = 2 * sg + jj;
            if (j < nsub) {
                float kk[16]; float eb = 1.f;
#pragma unroll
                for (int t = 0; t < 16; ++t) {
                    const float ff = bf2f(hfv[jj][t]); const float qv = bf2f(hqv[jj][t]);
                    const float sg1 = sigm(ff); const float f = lb + (1.0f - lb) * sg1; eb *= f;
                    const float kv = (1.0f - lb) * (1.0f - sg1);
                    const float ebi = __builtin_amdgcn_rcpf(eb);
                    kk[t] = kv * ebi;
                    Qb[(16 * j + t) * 136 + dk] = (bf16_t)f2bf(siluf(qv) * eb);
                    Kb[(16 * j + t) * 136 + dk] = (bf16_t)f2bf(kk[t]); }
                const float ebe = eb;
#pragma unroll
                for (int t = 0; t < 16; t += 2) *(unsigned*)(Ket + (j * 128 + dk) * 20 + t) = pk2(kk[t] * ebe, kk[t + 1] * ebe);
                EBE[j * 128 + dk] = ebe;
            }
        }
    }
    { const int t = lane >> 2, v4 = (lane & 3) * 4;
#pragma unroll
      for (int j = 0; j < 8; ++j) { if (j < nsub) { bf16_t* vp = Vt + (j * 16 + v4) * 20 + t;
        vp[0] = (bf16_t)(vv[j].x & 0xffffu); vp[20] = (bf16_t)(vv[j].x >> 16); vp[40] = (bf16_t)(vv[j].y & 0xffffu); vp[60] = (bf16_t)(vv[j].y >> 16); } } }
    __syncthreads();
#define HG_ATT_SLOT(j_) (((lane >> 5) ? Kb : Qb) + (16 * (j_) + ((lane & 31) >> 1)) * 136 + 128 + 4 * (lane & 1))
    if (w < nsub) {
        f32x4 at = {0.f, 0.f, 0.f, 0.f};
#pragma unroll
        for (int ks = 0; ks < 4; ++ks) { const bf16x8 a = *(const bf16x8*)(Kb + (16 * w + lc) * 136 + 32 * ks + 8 * g), bq = *(const bf16x8*)(Qb + (16 * w + lc) * 136 + 32 * ks + 8 * g); at = mfma32(a, bq, at); }
#pragma unroll
        for (int r = 0; r < 4; ++r) at[r] = (4 * g + r <= lc) ? at[r] : 0.f;
        *(bf16x4*)HG_ATT_SLOT(w) = pack4(at);
    }
    if (tid < 128) { float d = 1.f;
        for (int j = 0; j < nsub; ++j) { DT[j * 128 + tid] = d; d *= EBE[j * 128 + tid]; }
        float* dec = (float*)((unsigned char*)P.out + DO_HGDEC); dec[(size_t)((b * 8 + hd) * NCH + ch) * 128 + tid] = d; }
    __syncthreads();
    {
        const int t = tid >> 2, sgm = tid & 3;
        if (t < 16 * nsub) { const int j = t >> 4; bf16_t* qo = PJ + (row0 + t) * PW + C_HQ + hd * 128 + 32 * sgm;
#pragma unroll
            for (int c8 = 0; c8 < 4; ++c8) { const u32x4 qw = *(const u32x4*)(Qb + t * 136 + 32 * sgm + 8 * c8); float f[8]; unpack8(qw, f);
                const f32x4 d0 = *(const f32x4*)(DT + j * 128 + 32 * sgm + 8 * c8), d1 = *(const f32x4*)(DT + j * 128 + 32 * sgm + 8 * c8 + 4);
                u32x4 o; o.x = pk2(f[0] * d0[0], f[1] * d0[1]); o.y = pk2(f[2] * d0[2], f[3] * d0[3]); o.z = pk2(f[4] * d1[0], f[5] * d1[1]); o.w = pk2(f[6] * d1[2], f[7] * d1[3]);
                *(u32x4*)(qo + 8 * c8) = o; } }
    }
    f32x4 S[8];
#pragma unroll
    for (int kt = 0; kt < 8; ++kt) S[kt] = (f32x4){0.f, 0.f, 0.f, 0.f};
#pragma unroll
    for (int j = 0; j < 8; ++j) {
        if (j < nsub) {
            const bf16x4 vf = *(const bf16x4*)(Vt + (j * 16 + lc) * 20 + 4 * g);
            const bf16x4 atj = *(const bf16x4*)HG_ATT_SLOT(j);
            f32x4 o = mfma16(vf, atj, (f32x4){0.f, 0.f, 0.f, 0.f});
            if (j > 0) {
#pragma unroll
                for (int kt = 0; kt < 8; ++kt) { const bf16x4 qf = *(const bf16x4*)(Qb + (16 * j + lc) * 136 + 16 * kt + 4 * g); o = mfma16(pack4(S[kt]), qf, o); } }
            { u32x2 wv; wv.x = pk2(o[0], o[1]); wv.y = pk2(o[2], o[3]); *(u32x2*)(PJ + (row0 + 16 * j + lc) * PW + C_HI + hd * 128 + 16 * w + 4 * g) = wv; }
#pragma unroll
            for (int kt = 0; kt < 8; ++kt) { const f32x4 eb = *(const f32x4*)(EBE + j * 128 + 16 * kt + 4 * g);
                const bf16x4 kf = *(const bf16x4*)(Ket + (j * 128 + 16 * kt + lc) * 20 + 4 * g);
                S[kt] = mfma16(kf, vf, S[kt] * eb); }
        }
    }
#pragma unroll
    for (int kt = 0; kt < 8; ++kt) { u32x2 wv; wv.x = pk2(S[kt][0], S[kt][1]); wv.y = pk2(S[kt][2], S[kt][3]); *(u32x2*)(HS + (16 * w + lc) * 128 + 16 * kt + 4 * g) = wv; }
    __syncthreads();
}

#undef HG_ATT_SLOT
__device__ __forceinline__ void hg_passB(const Ptrs& P, int l, int b, int hd, int ch, unsigned char* lds, int tid, bool dost) {
    bf16_t* PJ = (bf16_t*)(P.ws + WS_R);
    const int lane = tid & 63, w = tid >> 6, lc = lane & 15, g = lane >> 4;
    const int nsub = (ch == 0) ? 1 : 8;
    const size_t row0 = (ch == 0) ? (size_t)(MMAIN + b * NMETA) : (size_t)(b * SEQ + 128 * (ch - 1));
    float* SSQ = (float*)(lds + HG_SSQ);
    const bf16_t* HS = (const bf16_t*)((unsigned char*)P.out + DO_HGS) + (size_t)((b * 8 + hd) * NCH + ch) * 16384;
    bf16x8 sfr[4];
#pragma unroll
    for (int ks = 0; ks < 4; ++ks) sfr[ks] = *(const bf16x8*)(HS + (16 * w + lc) * 128 + 32 * ks + 8 * g);
    u32x2 ol[8], gv_[8];
#pragma unroll
    for (int j = 0; j < 8; ++j) { ol[j] = (u32x2){0u, 0u}; gv_[j] = ol[j];
        if (j < nsub) { const bf16_t* rp = PJ + (row0 + 16 * j + lc) * PW + hd * 128 + 16 * w + 4 * g; ol[j] = *(const u32x2*)(rp + C_HI); gv_[j] = *(const u32x2*)(rp + C_HG); } }
    bf16x8 qf[8][4];
#pragma unroll
    for (int j = 0; j < 8; ++j)
#pragma unroll
        for (int ks = 0; ks < 4; ++ks) { qf[j][ks] = (bf16x8){0, 0, 0, 0, 0, 0, 0, 0}; if (j < nsub) qf[j][ks] = *(const bf16x8*)(PJ + (row0 + 16 * j + lc) * PW + C_HQ + hd * 128 + 32 * ks + 8 * g); }
    f32x4 oo[8];
#pragma unroll
    for (int j = 0; j < 8; ++j) { f32x4 o = {bflo(ol[j].x), bfhi(ol[j].x), bflo(ol[j].y), bfhi(ol[j].y)};
#pragma unroll
        for (int ks = 0; ks < 4; ++ks) o = mfma32(sfr[ks], qf[j][ks], o);
        oo[j] = o; }
#pragma unroll
    for (int j = 0; j < 8; ++j) { float part = (oo[j][0] * oo[j][0] + oo[j][1] * oo[j][1]) + (oo[j][2] * oo[j][2] + oo[j][3] * oo[j][3]);
        part += shx(part, 16, lane); part += shx(part, 32, lane); if (g == 0) SSQ[w * 128 + 16 * j + lc] = part; }
    __syncthreads();
    const f32x4 nw = *(const f32x4*)(P.hg_norm_w + l * 128 + 16 * w + 4 * g);
#pragma unroll
    for (int j = 0; j < 8; ++j) {
        if (j < nsub) {
            float tot = 0.f;
#pragma unroll
            for (int ww = 0; ww < 8; ++ww) tot += SSQ[ww * 128 + 16 * j + lc];
            const float rstd = 1.0f / sqrtf(tot * (1.0f / 128.0f) + EPS);
            bf16_t* gp = PJ + (row0 + 16 * j + lc) * PW + C_HG + hd * 128 + 16 * w + 4 * g;
            const u32x2 gv = gv_[j];
            u32x2 wv; wv.x = pk2(oo[j][0] * rstd * nw[0] * siluf(bflo(gv.x)), oo[j][1] * rstd * nw[1] * siluf(bfhi(gv.x)));
            wv.y = pk2(oo[j][2] * rstd * nw[2] * siluf(bflo(gv.y)), oo[j][3] * rstd * nw[3] * siluf(bfhi(gv.y)));
            if (dost) *(u32x2*)gp = wv;
        }
    }
    __syncthreads();
}

__device__ __forceinline__ void scan_phase(const Ptrs& P, int tid) {
    constexpr int gsz = NGRID * 512;
    bf16_t* ST = (bf16_t*)(P.ws + WS_X); const float* decs = (const float*)((const unsigned char*)P.out + DO_SSDDEC);
    bf16_t* HS = (bf16_t*)((unsigned char*)P.out + DO_HGS); const float* dech = (const float*)((const unsigned char*)P.out + DO_HGDEC);
    for (int gid = blockIdx.x * 512 + tid; gid < 131072; gid += gsz) {
        const int bhs = gid >> 12, b = bhs >> 4, h = bhs & 15, idx = (gid & 4095) * 2;
        const int bh = gid >> 13, e = (gid & 8191) * 2, dk = e & 127;
        float r0 = 0.f, r1 = 0.f, q0 = 0.f, q1 = 0.f;
        for (int c0 = 0; c0 < NCH; c0 += 16) { unsigned v[16], w[16]; float d[16], f0[16], f1[16];
#pragma unroll
            for (int k = 0; k < 16; ++k) { const int ch = (c0 + k < NCH) ? c0 + k : NCH - 1;
                v[k] = *(const unsigned*)(ST + (size_t)((b * NCH + ch) * 16 + h) * 8192 + idx); d[k] = decs[(b * NCH + ch) * 16 + h];
                w[k] = *(const unsigned*)(HS + (size_t)(bh * NCH + ch) * 16384 + e); f0[k] = dech[(size_t)(bh * NCH + ch) * 128 + dk]; f1[k] = dech[(size_t)(bh * NCH + ch) * 128 + dk + 1]; }
#pragma unroll
            for (int k = 0; k < 16; ++k) { if (c0 + k < NCH) {
                *(unsigned*)(ST + (size_t)((b * NCH + c0 + k) * 16 + h) * 8192 + idx) = pk2(r0, r1); r0 = r0 * d[k] + bflo(v[k]); r1 = r1 * d[k] + bfhi(v[k]);
                *(unsigned*)(HS + (size_t)(bh * NCH + c0 + k) * 16384 + e) = pk2(q0, q1); q0 = q0 * f0[k] + bflo(w[k]); q1 = q1 * f1[k] + bfhi(w[k]); } } }
    }
}

__device__ __forceinline__ void ffn_act_phase(const Ptrs& P, int l, int half, int gw, int NGW, int lane) {
    const bf16_t* A2 = (const bf16_t*)(P.ws + WS_R); bf16_t* G2 = (bf16_t*)(P.ws + WS_R + (size_t)16640 * 11264 * 2);
    const float* cw = P.ffn_conv_w + (size_t)l * 3 * 2 * DFF; const float* cb = P.ffn_conv_b + (size_t)l * 2 * DFF;
    const int nblk = (half == 1) ? 513 : 512;
    for (int it = gw; it < nblk * 11; it += NGW) {
        const int rb = it / 11, cg = it - rb * 11, f0 = (cg * 64 + lane) * 8;
        float wg[3][8], wu[3][8], bg[8], bu[8];
#pragma unroll
        for (int k = 0; k < 3; ++k) { const f32x4 a = *(const f32x4*)(cw + k * 2 * DFF + f0), b2 = *(const f32x4*)(cw + k * 2 * DFF + f0 + 4), c = *(const f32x4*)(cw + k * 2 * DFF + DFF + f0), d = *(const f32x4*)(cw + k * 2 * DFF + DFF + f0 + 4);
#pragma unroll
            for (int e = 0; e < 4; ++e) { wg[k][e] = a[e]; wg[k][4 + e] = b2[e]; wu[k][e] = c[e]; wu[k][4 + e] = d[e]; } }
        { const f32x4 a = *(const f32x4*)(cb + f0), b2 = *(const f32x4*)(cb + f0 + 4), c = *(const f32x4*)(cb + DFF + f0), d = *(const f32x4*)(cb + DFF + f0 + 4);
#pragma unroll
          for (int e = 0; e < 4; ++e) { bg[e] = a[e]; bg[4 + e] = b2[e]; bu[e] = c[e]; bu[4 + e] = d[e]; } }
        const int lr0 = rb * 32; const bool meta = (rb == 512);
        u32x4 g2 = {0u, 0u, 0u, 0u}, g1 = g2, u2 = g2, u1 = g2;
        if (!meta) { const int r2 = (rb == 0) ? (SEQ + half * 16 + 14) : lr0 - 2, r1 = (rb == 0) ? (SEQ + half * 16 + 15) : lr0 - 1;
            g2 = *(const u32x4*)(A2 + (size_t)r2 * 11264 + f0); u2 = *(const u32x4*)(A2 + (size_t)r2 * 11264 + DFF + f0);
            g1 = *(const u32x4*)(A2 + (size_t)r1 * 11264 + f0); u1 = *(const u32x4*)(A2 + (size_t)r1 * 11264 + DFF + f0); }
        u32x4 gn[4], un[4];
#pragma unroll
        for (int i = 0; i < 4; ++i) { gn[i] = *(const u32x4*)(A2 + (size_t)(lr0 + i) * 11264 + f0); un[i] = *(const u32x4*)(A2 + (size_t)(lr0 + i) * 11264 + DFF + f0); }
#pragma unroll 1
        for (int i0 = 0; i0 < 32; i0 += 4) {
            u32x4 gc[4], uc[4];
#pragma unroll
            for (int i = 0; i < 4; ++i) { gc[i] = gn[i]; uc[i] = un[i]; }
            if (i0 + 4 < 32) {
#pragma unroll
                for (int i = 0; i < 4; ++i) { gn[i] = *(const u32x4*)(A2 + (size_t)(lr0 + i0 + 4 + i) * 11264 + f0); un[i] = *(const u32x4*)(A2 + (size_t)(lr0 + i0 + 4 + i) * 11264 + DFF + f0); } }
#pragma unroll
            for (int i = 0; i < 4; ++i) {
                if (meta && ((i0 + i) & 15) == 0) { g2 = (u32x4){0u, 0u, 0u, 0u}; g1 = g2; u2 = g2; u1 = g2; }
                float a2[8], a1[8], a0[8], c2[8], c1[8], c0[8], o[8];
                unpack8(g2, a2); unpack8(g1, a1); unpack8(gc[i], a0); unpack8(u2, c2); unpack8(u1, c1); unpack8(uc[i], c0);
#pragma unroll
                for (int e = 0; e < 8; ++e) { const float gv = bg[e] + wg[0][e] * a2[e] + wg[1][e] * a1[e] + wg[2][e] * a0[e]; const float uv = bu[e] + wu[0][e] * c2[e] + wu[1][e] * c1[e] + wu[2][e] * c0[e]; o[e] = siluf(gv) * uv; }
                u32x4 wv; wv.x = pk2(o[0], o[1]); wv.y = pk2(o[2], o[3]); wv.z = pk2(o[4], o[5]); wv.w = pk2(o[6], o[7]);
                pg8::store16_wt(G2 + (size_t)(lr0 + i0 + i) * DFF + f0, wv);
                g2 = g1; g1 = gc[i]; u2 = u1; u1 = uc[i];
            }
        }
    }
}

#define XB_TMO      128
#define XB_XCNT(j)  (256  + 64 * (j))
#define XB_XSUB(j)  (1280 + 64 * (j))
#define XB_XGEN(j)  (2304 + 64 * (j))
#define XB_TOP      3328
#define XB_TOPGEN   3392
#define XCD_BAR_WORDS 3456
#define XB_SPIN_CAP (1u << 18)

__device__ __forceinline__ unsigned xb_ld(unsigned* p)              { return __hip_atomic_load(p, __ATOMIC_RELAXED, __HIP_MEMORY_SCOPE_AGENT); }
__device__ __forceinline__ unsigned xb_add(unsigned* p, unsigned v) { return __hip_atomic_fetch_add(p, v, __ATOMIC_RELAXED, __HIP_MEMORY_SCOPE_AGENT); }
__device__ __forceinline__ unsigned xb_xcc_id() { return (unsigned)__builtin_amdgcn_s_getreg((3 << 11) | 20) & 0xFu; }
#define XB_SPIN(cond, bar) do { unsigned _sp = 0; while (cond) { __builtin_amdgcn_s_sleep(1); \
    if ((++_sp & 255u) == 0u) { if (xb_ld(&(bar)[XB_TMO])) break; if (_sp > XB_SPIN_CAP) { atomicAdd(&(bar)[XB_TMO], 1u); break; } } } } while (0)

struct XcdBarrier {
    unsigned* bar; unsigned x;
    volatile LAS unsigned* st;
};

__device__ __forceinline__ XcdBarrier xcd_barrier_post(unsigned* bar, volatile LAS unsigned* st) {
    XcdBarrier b; b.bar = bar; b.x = xb_xcc_id(); b.st = st;
    if (threadIdx.x == 0) (void)xb_add(&bar[XB_XCNT(b.x)], 1u);
    return b;
}
__device__ __forceinline__ void xcd_barrier_complete(unsigned* bar, unsigned x, unsigned& nloc, unsigned& nx) {
    const unsigned G = gridDim.x * gridDim.y * gridDim.z;
    unsigned sum, cnt, mine, sp = 0u;
    for (;;) {
        sum = 0u; cnt = 0u; mine = 0u;
#pragma unroll
        for (unsigned j = 0; j < 16; ++j) { const unsigned c = xb_ld(&bar[XB_XCNT(j)]); sum += c; cnt += (c > 0u) ? 1u : 0u; mine = (j == x) ? c : mine; }
        if (sum == G) break;
        __builtin_amdgcn_s_sleep(1);
        if ((++sp & 255u) == 0u) { if (xb_ld(&bar[XB_TMO])) break; if (sp > XB_SPIN_CAP) { atomicAdd(&bar[XB_TMO], 1u); break; } }
    }
    nloc = mine > 0u ? mine : 1u; nx = cnt > 0u ? cnt : 1u;
}

__device__ __forceinline__ void xcd_barrier(const XcdBarrier& b) {
    asm volatile("s_waitcnt vmcnt(0)" ::: "memory");
    __syncthreads();
    if (pg8::wg_tid((PG8_LAS unsigned char*)b.st - (LDS_BYTES - 16)) == 0) {
        unsigned* bar = b.bar;
        __builtin_amdgcn_s_waitcnt(0);
        unsigned nloc = b.st[0], nx = b.st[1];
        if (nloc == 0u) { xcd_barrier_complete(bar, b.x, nloc, nx); b.st[0] = nloc; b.st[1] = nx; }
        const unsigned old = xb_add(&bar[XB_XSUB(b.x)], 1u);
        const unsigned gen = old / nloc;
        if (old + 1u == (gen + 1u) * nloc) {
            __builtin_amdgcn_fence(__ATOMIC_RELEASE, "agent");
            asm volatile("s_waitcnt vmcnt(0)" ::: "memory");
            const unsigned og = xb_add(&bar[XB_TOP], 1u);
            const unsigned tg = og / nx;
            if (og + 1u == (tg + 1u) * nx) xb_add(&bar[XB_TOPGEN], 1u);
            else XB_SPIN(xb_ld(&bar[XB_TOPGEN]) == tg, bar);
            __builtin_amdgcn_fence(__ATOMIC_ACQUIRE, "agent");
            xb_add(&bar[XB_XGEN(b.x)], 1u);
            asm volatile("s_waitcnt vmcnt(0)" ::: "memory");
        } else {
            XB_SPIN(xb_ld(&bar[XB_XGEN(b.x)]) == gen, bar);
            __builtin_amdgcn_fence(__ATOMIC_ACQUIRE, "agent");
            asm volatile("s_waitcnt vmcnt(0)" ::: "memory");
        }
    }
    __syncthreads();
}

typedef float f32x16 __attribute__((ext_vector_type(16)));
template <int MODE, int NSEL> __device__ __forceinline__ void skinny_phase(const bf16_t* A, int lda, size_t asel, const bf16_t* Bt, size_t bsel, int K, int N, unsigned char* lds, int tid, int bx, int G,
                                                                          const bf16_t* GT, bf16_t* Ob, int ldo, bf16_t* H) {
    const int lane = tid & 63, w = tid >> 6, kw = K >> 3;
    float* red = (float*)lds;
    for (int blk = G - 1 - bx; blk < (N >> 5); blk += G) {
#pragma unroll
        for (int s = 0; s < NSEL; ++s) {
            const bf16_t* ap = A + s * asel + (size_t)(lane & 31) * lda + w * kw + 8 * (lane >> 5);
            const bf16_t* bp = Bt + s * bsel + (size_t)(blk * 32 + (lane & 31)) * K + w * kw + 8 * (lane >> 5);
            f32x16 acc;
#pragma unroll
            for (int i = 0; i < 16; ++i) acc[i] = 0.f;
#pragma unroll 8
            for (int k = 0; k < kw; k += 16) { const bf16x8 bv = *(const bf16x8*)(bp + k); const bf16x8 av = *(const bf16x8*)(ap + k); acc = __builtin_amdgcn_mfma_f32_32x32x16_bf16(bv, av, acc, 0, 0, 0); }
#pragma unroll
            for (int i = 0; i < 16; ++i) red[((s * 8 + w) * 16 + i) * 64 + lane] = acc[i];
        }
        __syncthreads();
        const int row = lane & 31, col = blk * 32 + 8 * (w >> 1) + 4 * (lane >> 5) + 2 * (w & 1);
        float v[NSEL][2];
#pragma unroll
        for (int s = 0; s < NSEL; ++s)
#pragma unroll
            for (int e = 0; e < 2; ++e) { float t = 0.f;
#pragma unroll
                for (int ww = 0; ww < 8; ++ww) t += red[((s * 8 + ww) * 16 + 2 * w + e) * 64 + lane]; v[s][e] = t; }
        if (MODE == 1) { *(unsigned*)(Ob + (size_t)row * ldo + col) = pk2(sigm(v[0][0]), sigm(v[0][1])); }
        else if (MODE == 2) { float o0 = 0.f, o1 = 0.f;
#pragma unroll
            for (int s = 0; s < NSEL; ++s) { const unsigned gwd = *(const unsigned*)(GT + (size_t)row * 6144 + s * 2048 + col); o0 += bflo(gwd) * v[s][0]; o1 += bfhi(gwd) * v[s][1]; }
            *(unsigned*)(Ob + (size_t)(MMAIN + row) * ldo + col) = pk2(o0, o1); }
        else if (MODE == 3) { unsigned* hp = (unsigned*)(H + (size_t)(MMAIN + row) * DM + col); const unsigned hw = *hp; *hp = pk2(bflo(hw) + v[0][0], bfhi(hw) + v[0][1]); }
        else { *(unsigned*)(Ob + (size_t)(16384 + row) * ldo + col) = pk2(v[0][0], v[0][1]); }
        __syncthreads();
    }
}

#ifndef GEMM_ALIGN
#define GEMM_ALIGN true
#endif
#ifndef GEMM_SP2
#define GEMM_SP2 true
#endif
#ifndef REP_ATT
#define REP_ATT 1
#endif
#ifndef REP_MIXB
#define REP_MIXB 1
#endif
#ifndef REP_SKIPSSD
#define REP_SKIPSSD 0
#endif
#ifndef REP_G1
#define REP_G1 1
#endif
#ifndef REP_MIXA
#define REP_MIXA 1
#endif
#ifndef REP_MEM
#define REP_MEM 1
#endif
#ifndef REP_SYNC
#define REP_SYNC 1
#endif
#define GSYNC() do { for (int rs_ = 0; rs_ < REP_SYNC; ++rs_) xcd_barrier(xbar); } while (0)
#ifndef PH_MASK
#define PH_MASK 0xFFFFF
#endif
#define PH(b) ((PH_MASK >> (b)) & 1)
typedef const __attribute__((address_space(4))) Ptrs* KPtr;
__global__ void __launch_bounds__(512, 2) fwd_megakernel(Ptrs Parg) {
    extern __shared__ __attribute__((aligned(16))) unsigned char lds[];
    cg::grid_group grid = cg::this_grid();
    constexpr int G = NGRID, NGW = NGRID * 8; const int bx = blockIdx.x;
    PG8_LAS unsigned char* glds = (PG8_LAS unsigned char*)lds;
    volatile LAS unsigned* misc = (volatile LAS unsigned*)((LAS unsigned char*)lds + (LDS_BYTES - 16));
    if (threadIdx.x < 4) misc[threadIdx.x] = 0u;
    if ((threadIdx.x & 63) == 0) { const unsigned hw = (unsigned)__builtin_amdgcn_s_getreg((5 << 11) | 4) & 63u; ((volatile LAS unsigned*)((LAS unsigned char*)lds + pg8::WMAP_OFF))[hw] = threadIdx.x >> 6; }
    __syncthreads();
    const XcdBarrier xbar = xcd_barrier_post((unsigned*)Parg.ws, misc);
    grid.sync();
#define TIDS const int tid = pg8::wg_tid(glds); const int lane = tid & 63, wave = tid >> 6, gw = bx * 8 + wave; (void)lane; (void)gw; (void)wave; PHP
#define PHP KPtr kp_ = (KPtr)__builtin_amdgcn_kernarg_segment_ptr(); asm volatile("" : "+s"(kp_)); Ptrs P; __builtin_memcpy(&P, (const void*)kp_, sizeof(Ptrs)); \
    unsigned char* dob = (unsigned char*)P.out; bf16_t* U = (bf16_t*)(P.ws + WS_U); bf16_t* PJ = (bf16_t*)(P.ws + WS_R); bf16_t* H = (bf16_t*)(P.ws + WS_H); \
    bf16_t* WinT = (bf16_t*)(dob + DO_WIN); bf16_t* WgT = (bf16_t*)(dob + DO_WG); bf16_t* WbT = (bf16_t*)(dob + DO_WB); bf16_t* WoT = (bf16_t*)(dob + DO_WO); \
    bf16_t* WupT = (bf16_t*)(dob + DO_WUP); bf16_t* WdT = (bf16_t*)(dob + DO_WD); bf16_t* GT = (bf16_t*)(P.ws + WS_X); \
    (void)U; (void)PJ; (void)H; (void)WinT; (void)WgT; (void)WbT; (void)WoT; (void)WupT; (void)WdT; (void)GT

    for (int l = 0; l < 2; ++l) {
        for (int rep = 0; rep < REP_MEM; ++rep) if (PH(0)) { TIDS; convert_weights(P, l, lds, gw, NGW, lane, wave); }
        for (int rep = 0; rep < REP_MEM; ++rep) if (PH(1)) { TIDS; if (l == 0) norm_phase<1>(P, P.attn_norm_w, gw, NGW, lane); else norm_phase<0>(P, P.attn_norm_w + l * DM, gw, NGW, lane); }
        GSYNC();
        for (int rep = 0; rep < REP_G1; ++rep) if (PH(2)) { PHP; pg8::Gemm g{U, WinT, DM, DM, 0, 0, 0}; pg8::Sched S{129, PW / 256, 1, G, bx, 0, 129};
          pg8::EpiStore<0> E{PJ, PW, 0};
          pg8::gemm_phase<pg8::EpiStore<0>, pg8::Sched, GEMM_ALIGN, GEMM_SP2>(glds, g, S, E); }
        if (PH(3)) { TIDS; dt_phase(P, gw, NGW, lane); }
        GSYNC();
        if (PH(4)) { TIDS; attn_tables(P, lds, tid);
          unsigned* qctr = (unsigned*)P.ws + 8192 + 64 * (2 * l);
          unsigned nxt = 0u; if (tid == 0) misc[2] = atomicAdd(qctr, 1u);
          __syncthreads();
          int it = (int)__builtin_amdgcn_readfirstlane(misc[2]);
          while (it < 28 * NCH) { const int t2 = pg8::wg_tid(glds);
              if (t2 == 0) nxt = atomicAdd(qctr, 1u);
              if (it < 16 * NCH) { const int ch = it % NCH, bh = it / NCH; hg_unit(P, l, bh >> 3, bh & 7, ch, lds, t2); }
              else if (it < 24 * NCH) { const int i2 = it - 16 * NCH; const int ch = i2 % NCH, bg = i2 / NCH; ssd_passA(P, l, bg >> 2, ch, bg & 3, lds, t2); }
              else { const int i2 = it - 24 * NCH; const int n = i2 % NCH, bg = i2 / NCH; attn_unit(P, l, bg >> 1, bg & 1, n, lds, t2, true); }
              if (t2 == 0) misc[2] = nxt;
              __syncthreads();
              it = (int)__builtin_amdgcn_readfirstlane(misc[2]); } }
        GSYNC();
        if (PH(7)) { TIDS; scan_phase(P, tid); }
        GSYNC();
        if (PH(8)) { TIDS;
          unsigned* qctr = (unsigned*)P.ws + 8192 + 64 * (2 * l + 1);
          unsigned nxt = 0u; if (tid == 0) misc[2] = atomicAdd(qctr, 1u);
          __syncthreads();
          int it = (int)__builtin_amdgcn_readfirstlane(misc[2]);
          while (it < 24 * NCH) { const int t2 = pg8::wg_tid(glds);
              if (t2 == 0) nxt = atomicAdd(qctr, 1u);
              if (it < 8 * NCH) { const int ch = it % NCH, bg = it / NCH; ssd_passB(P, l, bg >> 2, ch, bg & 3, lds, t2, true); }
              else { const int i2 = it - 8 * NCH; const int ch = i2 % NCH, bh = i2 / NCH; hg_passB(P, l, bh >> 3, bh & 7, ch, lds, t2, true); }
              if (t2 == 0) misc[2] = nxt;
              __syncthreads();
              it = (int)__builtin_amdgcn_readfirstlane(misc[2]); } }
        GSYNC();
        if (PH(10)) { PHP; pg8::Gemm g{U, WgT, DM, DM, 0, 0, 0}; pg8::Sched S{128, 24, 1, G, bx, 0, 128};
          pg8::EpiGate E{pg8::GateMap{PJ + C_HQ, GT, (bf16_t*)(dob + DO_GB)}};
          pg8::gemm_phase<pg8::EpiGate, pg8::Sched, GEMM_ALIGN, GEMM_SP2>(glds, g, S, E); }
        { TIDS; skinny_phase<1, 1>(U + (size_t)MMAIN * DM, DM, 0, WgT, 0, DM, 6144, lds, tid, bx, G, nullptr, (bf16_t*)(dob + DO_GMETA), 6144, nullptr); }
        GSYNC();
        if (PH(11)) { PHP; pg8::Gemm g{PJ + C_AQ, WbT, 1024, PW, 0, (size_t)1024, (size_t)DM * 1024}; pg8::Sched S{128, 8, 3, G, bx, 0, 128};
          pg8::EpiMerge E{pg8::GateMap{PJ + C_HQ, GT, (bf16_t*)(dob + DO_GB)}, PJ + C_XBC, PW};
          pg8::gemm_phase<pg8::EpiMerge, pg8::Sched, GEMM_ALIGN, GEMM_SP2>(glds, g, S, E); }
        { TIDS; skinny_phase<2, 3>(PJ + (size_t)MMAIN * PW + C_AQ, PW, 1024, WbT, (size_t)DM * 1024, 1024, DM, lds, tid, bx, G, (const bf16_t*)(dob + DO_GMETA), PJ + C_XBC, PW, nullptr); }
        GSYNC();
        if (PH(12)) { PHP; pg8::Gemm g{PJ + C_XBC, WoT, DM, PW, 0, 0, 0}; pg8::Sched S{128, 8, 1, G, bx, 0, 128};
          pg8::EpiResid E{H};
          pg8::gemm_phase<pg8::EpiResid, pg8::Sched, GEMM_ALIGN, GEMM_SP2>(glds, g, S, E); }
        { TIDS; skinny_phase<3, 1>(PJ + (size_t)MMAIN * PW + C_XBC, PW, 0, WoT, 0, DM, DM, lds, tid, bx, G, nullptr, nullptr, 0, H); }
        GSYNC();
        if (PH(13)) { TIDS; norm_phase<0>(P, P.ffn_norm_w + l * DM, gw, NGW, lane); }
        GSYNC();
        for (int half = 0; half < 2; ++half) {
            if (PH(14)) { PHP; bf16_t* A2 = PJ; pg8::Gemm g{U, WupT, DM, DM, 0, 0, 0}; pg8::Sched S{64, 44, 1, G, bx, 64 * half, 64};
              pg8::EpiStore<0> E{A2, 11264, 1};
              pg8::gemm_phase<pg8::EpiStore<0>, pg8::Sched, GEMM_ALIGN, GEMM_SP2>(glds, g, S, E); }
            if (half == 0) { TIDS; skinny_phase<4, 1>(U + (size_t)MMAIN * DM, DM, 0, WupT, 0, DM, 2 * DFF, lds, tid, bx, G, nullptr, PJ, 2 * DFF, nullptr); }
            GSYNC();
            for (int rep = 0; rep < REP_MEM; ++rep) if (PH(15)) { TIDS; ffn_act_phase(P, l, half, gw, NGW, lane); }
            GSYNC();
            if (PH(16)) { PHP; bf16_t* G2 = (bf16_t*)(P.ws + WS_R + (size_t)16640 * 11264 * 2); pg8::Gemm g{G2, WdT, DFF, DFF, 1, 0, 0}; pg8::Sched S{64, 8, 1, G, bx, 64 * half, 64};
              pg8::EpiResid E{H};
              pg8::gemm_phase<pg8::EpiResid, pg8::Sched, GEMM_ALIGN, GEMM_SP2>(glds, g, S, E); }
            if (half == 1) { TIDS; skinny_phase<3, 1>((const bf16_t*)(P.ws + WS_R + (size_t)16640 * 11264 * 2) + (size_t)16384 * DFF, DFF, 0, WdT, 0, DFF, DM, lds, tid, bx, G, nullptr, nullptr, 0, H); }
            GSYNC();
        }
    }
    if (PH(17)) { TIDS; norm_phase<2>(P, P.final_norm_w, gw, NGW, lane); }
}

extern "C" void kernel_launch(void* const* d_in, const int* in_sizes, int n_in, void* d_out, int out_size, void* d_ws, size_t ws_size, hipStream_t stream) {
    static int grid = 0;
    if (grid == 0) {
        if (n_in != 22 || ws_size < WS_NEED) { fprintf(stderr, "kernel_launch: unexpected n_in %d or workspace %zu < %zu\n", n_in, ws_size, (size_t)WS_NEED); grid = -1; return; }
        int dev = 0, cus = 0, per_cu = 0;
        hipGetDevice(&dev); hipDeviceGetAttribute(&cus, hipDeviceAttributeMultiprocessorCount, dev);
        if (hipFuncSetAttribute((const void*)fwd_megakernel, hipFuncAttributeMaxDynamicSharedMemorySize, LDS_BYTES) != hipSuccess) { fprintf(stderr, "hipFuncSetAttribute failed\n"); }
        if (hipOccupancyMaxActiveBlocksPerMultiprocessor(&per_cu, (const void*)fwd_megakernel, 512, LDS_BYTES) != hipSuccess || per_cu < 1) per_cu = 1;
        (void)hipGetLastError();
        grid = NGRID; if (cus < NGRID) { fprintf(stderr, "kernel_launch: built for %d CUs, device has %d\n", NGRID, cus); grid = -1; return; }
    }
    if (grid < 0) return;
    if (hipMemsetAsync(d_ws, 0, 65536, stream) != hipSuccess) { fprintf(stderr, "memset failed\n"); return; }
    Ptrs p{};
    const float** pp = (const float**)&p;
    for (int i = 0; i < 22; ++i) pp[i] = (const float*)d_in[i];
    p.out = (float*)d_out; p.ws = (unsigned char*)d_ws;
    void* args[] = {&p};
    hipError_t e = hipLaunchCooperativeKernel((const void*)fwd_megakernel, dim3(grid), dim3(512), args, LDS_BYTES, stream);
    if (e != hipSuccess) fprintf(stderr, "cooperative launch failed: %s (grid %d)\n", hipGetErrorString(e), grid);
}
```
